# Optimizing an MI355X kernel written in HIP

```python
import math
import jax, jax.numpy as jnp
from jax import lax
import numpy as np

D_MODEL = 2048
BATCH = 2
SEQ = 4096
DEPTH = 1

CHUNK = 64
Q_BLOCK = 128
MIX_WIDTH = D_MODEL
MLA_HEADS = 8
MLA_Q_RANK = 512
MLA_KV_RANK = 256
MLA_NOPE_DIM = 128
MLA_ROPE_DIM = 64
MLA_V_DIM = 128
FOX_HEADS = 8
FOX_HEAD_DIM = 128
D_FF = 5632
MACARON_WEIGHT = 0.5
ROPE_THETA = 10000.0
EPS = 1e-6
N_MOD = 9
FOX_WIDTH = FOX_HEADS * FOX_HEAD_DIM
IN_SIZES = (MLA_Q_RANK, MLA_KV_RANK, MLA_ROPE_DIM, FOX_WIDTH, FOX_WIDTH, FOX_WIDTH, FOX_HEADS)
IN_WIDTH = sum(IN_SIZES)
IN_OFFSETS = tuple(int(v) for v in np.cumsum(IN_SIZES)[:-1])

kernel_name = "hybrid_mla_fox_macaron_adaln_block"


def rmsnorm(x, g):
    xf = x.astype(jnp.float32)
    xf = xf * lax.rsqrt(jnp.mean(xf * xf, axis=-1, keepdims=True) + EPS)
    return xf.astype(x.dtype) * g


def modulate(h, shift, scale):
    return h * (1 + scale[:, None, :]) + shift[:, None, :]


def swiglu(h, w_gate, w_up, w_down):
    return (jax.nn.silu(h @ w_gate) * (h @ w_up)) @ w_down


def rotary(x, pos):
    half = x.shape[-1] // 2
    inv = ROPE_THETA ** (-jnp.arange(half, dtype=jnp.float32) / half)
    ang = pos.astype(jnp.float32)[:, None] * inv[None, :]
    cos = jnp.cos(ang)[None, :, None, :].astype(x.dtype)
    sin = jnp.sin(ang)[None, :, None, :].astype(x.dtype)
    x1, x2 = x[..., :half], x[..., half:]
    return jnp.concatenate([x1 * cos - x2 * sin, x1 * sin + x2 * cos], axis=-1)


def blocked_attention(q, k, v, scale, logit_fn):
    S = q.shape[1]
    outs = []
    for i in range(S // Q_BLOCK):
        q0 = i * Q_BLOCK
        kv_len = q0 + Q_BLOCK
        s = jnp.einsum('bqhd,bkhd->bhqk', q[:, q0:kv_len], k[:, :kv_len]).astype(jnp.float32) * scale
        p = jax.nn.softmax(logit_fn(s, q0, kv_len), axis=-1)
        outs.append(jnp.einsum('bhqk,bkhd->bqhd', p.astype(v.dtype), v[:, :kv_len]))
    return jnp.concatenate(outs, axis=1)


def chunk_causal_logits(s, q0, kv_len):
    t = q0 + jnp.arange(Q_BLOCK)
    src = jnp.arange(kv_len)
    mask = (src[None, :] // CHUNK) <= (t[:, None] // CHUNK)
    return jnp.where(mask[None, None], s, -jnp.inf)


def hybrid_mixer(h, pos, w_in, b_forget, g_q_a, w_uq, g_kv_a, w_ukv, w_o):
    B, S, _ = h.shape
    proj = h @ w_in
    q_a, kv_a, k_pe, fq, fk, fv, f_logit = jnp.split(proj, IN_OFFSETS, axis=-1)

    q = (rmsnorm(q_a, g_q_a) @ w_uq).reshape(B, S, MLA_HEADS, MLA_NOPE_DIM + MLA_ROPE_DIM)
    kv = (rmsnorm(kv_a, g_kv_a) @ w_ukv).reshape(B, S, MLA_HEADS, MLA_NOPE_DIM + MLA_V_DIM)
    k_nope, v_mla = kv[..., :MLA_NOPE_DIM], kv[..., MLA_NOPE_DIM:]
    q_mla = jnp.concatenate([q[..., :MLA_NOPE_DIM], rotary(q[..., MLA_NOPE_DIM:], pos)], axis=-1)
    k_rope = rotary(k_pe[:, :, None, :], pos)
    k_mla = jnp.concatenate(
        [k_nope, jnp.broadcast_to(k_rope, (B, S, MLA_HEADS, MLA_ROPE_DIM))], axis=-1)
    o_mla = blocked_attention(q_mla, k_mla, v_mla,
                              1.0 / math.sqrt(MLA_NOPE_DIM + MLA_ROPE_DIM), chunk_causal_logits)

    log_f = jax.nn.log_sigmoid((f_logit + b_forget).astype(jnp.float32))
    cum = jnp.cumsum(log_f, axis=1).transpose(0, 2, 1)

    def fox_logits(s, q0, kv_len):
        bias = cum[:, :, q0:kv_len, None] - cum[:, :, None, :kv_len]
        t = q0 + jnp.arange(Q_BLOCK)
        mask = jnp.arange(kv_len)[None, :] <= t[:, None]
        return jnp.where(mask[None, None], s + bias, -jnp.inf)

    o_fox = blocked_attention(fq.reshape(B, S, FOX_HEADS, FOX_HEAD_DIM),
                              fk.reshape(B, S, FOX_HEADS, FOX_HEAD_DIM),
                              fv.reshape(B, S, FOX_HEADS, FOX_HEAD_DIM),
                              1.0 / math.sqrt(FOX_HEAD_DIM), fox_logits)

    o = jnp.concatenate([o_mla.reshape(B, S, MLA_HEADS * MLA_V_DIM),
                         o_fox.reshape(B, S, FOX_WIDTH)], axis=-1)
    return o @ w_o


def setup_inputs(seed: int = 0) -> dict:
    key = jax.random.key(seed)
    ks = jax.random.split(key, 32)
    f32 = jnp.float32
    L, D = DEPTH, D_MODEL

    def w(k, shape, fan_in, mult=1.0):
        return jax.random.normal(k, shape, f32) * (mult * fan_in ** -0.5)

    def gain(k, dim):
        return 1.0 + 0.05 * jax.random.normal(k, (L, dim), f32)

    return {
        "x": jax.random.normal(ks[0], (BATCH, SEQ, D), f32),
        "c": jax.random.normal(ks[1], (BATCH, D), f32),
        "w_ada": w(ks[2], (L, D, N_MOD * D), D, 0.5),
        "b_ada": 0.02 * jax.random.normal(ks[3], (L, N_MOD * D), f32),
        "g_ffn1_pre": gain(ks[4], D),
        "g_ffn1_post": gain(ks[5], D),
        "w1_gate": w(ks[6], (L, D, D_FF), D),
        "w1_up": w(ks[7], (L, D, D_FF), D),
        "w1_down": w(ks[8], (L, D_FF, D), D_FF),
        "g_mix_pre": gain(ks[9], D),
        "g_mix_post": gain(ks[10], D),
        "w_in": w(ks[11], (L, D, IN_WIDTH), D),
        "b_forget": jax.random.uniform(ks[12], (L, FOX_HEADS), f32, 1.0, 4.0),
        "g_q_a": gain(ks[13], MLA_Q_RANK),
        "w_uq": w(ks[14], (L, MLA_Q_RANK, MLA_HEADS * (MLA_NOPE_DIM + MLA_ROPE_DIM)), MLA_Q_RANK),
        "g_kv_a": gain(ks[15], MLA_KV_RANK),
        "w_ukv": w(ks[16], (L, MLA_KV_RANK, MLA_HEADS * (MLA_NOPE_DIM + MLA_V_DIM)), MLA_KV_RANK),
        "w_o": w(ks[17], (L, MIX_WIDTH, D), MIX_WIDTH),
        "g_ffn2_pre": gain(ks[18], D),
        "g_ffn2_post": gain(ks[19], D),
        "w2_gate": w(ks[20], (L, D, D_FF), D),
        "w2_up": w(ks[21], (L, D, D_FF), D),
        "w2_down": w(ks[22], (L, D_FF, D), D_FF),
    }


def reference(x, c, w_ada, b_ada, g_ffn1_pre, g_ffn1_post, w1_gate, w1_up, w1_down,
              g_mix_pre, g_mix_post, w_in, b_forget, g_q_a, w_uq, g_kv_a, w_ukv, w_o,
              g_ffn2_pre, g_ffn2_post, w2_gate, w2_up, w2_down):
    pos = jnp.arange(x.shape[1])
    cond = jax.nn.silu(c)
    for l in range(DEPTH):
        mod = cond @ w_ada[l] + b_ada[l]
        sh1, sc1, gt1, sh2, sc2, gt2, sh3, sc3, gt3 = jnp.split(mod, N_MOD, axis=-1)
        h = modulate(rmsnorm(x, g_ffn1_pre[l]), sh1, sc1)
        y = rmsnorm(swiglu(h, w1_gate[l], w1_up[l], w1_down[l]), g_ffn1_post[l])
        x = x + MACARON_WEIGHT * gt1[:, None, :] * y
        h = modulate(rmsnorm(x, g_mix_pre[l]), sh2, sc2)
        y = hybrid_mixer(h, pos, w_in[l], b_forget[l], g_q_a[l], w_uq[l], g_kv_a[l], w_ukv[l], w_o[l])
        x = x + gt2[:, None, :] * rmsnorm(y, g_mix_post[l])
        h = modulate(rmsnorm(x, g_ffn2_pre[l]), sh3, sc3)
        y = rmsnorm(swiglu(h, w2_gate[l], w2_up[l], w2_down[l]), g_ffn2_post[l])
        x = x + MACARON_WEIGHT * gt3[:, None, :] * y
    return x
```

```cpp
#include <hip/hip_runtime.h>
#include <hip/hip_cooperative_groups.h>
#include <stdint.h>
#include <stdio.h>
namespace cg = cooperative_groups;

#define DEVI __device__ __forceinline__
typedef unsigned short bf16_t;
typedef short bf16x8 __attribute__((ext_vector_type(8)));
typedef float f32x4 __attribute__((ext_vector_type(4)));
typedef float f32x16 __attribute__((ext_vector_type(16)));
typedef unsigned u32x4 __attribute__((ext_vector_type(4)));
typedef unsigned u32x2 __attribute__((ext_vector_type(2)));

constexpr int DM = 2048, SEQ = 4096, NTOK = 8192, DFF = 5632, NMOD = 9 * DM;
constexpr float EPS = 1e-6f;
constexpr float LOG2E = 1.4426950408889634f;
constexpr int LDS_BYTES = 131072;

constexpr size_t WS_MOD = 0;
constexpr size_t WS_SS = WS_MOD + (size_t)2 * NMOD * 4;
constexpr size_t WS_ZERO_END = WS_SS + (size_t)5 * NTOK * 4;
constexpr size_t WS_ROPEC = WS_ZERO_END;
constexpr size_t WS_ROPES = WS_ROPEC + (size_t)SEQ * 32 * 4;
constexpr size_t WS_CUM = WS_ROPES + (size_t)SEQ * 32 * 4;
constexpr size_t WS_LOGF = WS_CUM + (size_t)16 * SEQ * 4;
constexpr size_t WS_BT1U = WS_LOGF + (size_t)NTOK * 8 * 4;
constexpr size_t WS_BT1D = WS_BT1U + (size_t)2 * DFF * DM * 2;
constexpr size_t WS_BT2U = WS_BT1D + (size_t)DM * DFF * 2;
constexpr size_t WS_BT2D = WS_BT2U + (size_t)2 * DFF * DM * 2;
constexpr size_t WS_BTIN = WS_BT2D + (size_t)DM * DFF * 2;
constexpr size_t WS_BTUQ = WS_BTIN + (size_t)4096 * DM * 2;
constexpr size_t WS_BTUKV = WS_BTUQ + (size_t)1536 * 512 * 2;
constexpr size_t WS_BTO = WS_BTUKV + (size_t)2048 * 256 * 2;
constexpr size_t WS_H = WS_BTO + (size_t)DM * DM * 2;
constexpr size_t WS_U = WS_H + (size_t)NTOK * DM * 2;
constexpr size_t WS_Y = WS_U + (size_t)NTOK * DFF * 2;
constexpr size_t WS_QA = WS_Y + (size_t)NTOK * DM * 2;
constexpr size_t WS_KVA = WS_QA + (size_t)NTOK * 512 * 2;
constexpr size_t WS_KR = WS_KVA + (size_t)NTOK * 256 * 2;
constexpr size_t WS_FQ = WS_KR + (size_t)NTOK * 64 * 2;
constexpr size_t WS_FK = WS_FQ + (size_t)NTOK * 1024 * 2;
constexpr size_t WS_VTF = WS_FK + (size_t)NTOK * 1024 * 2;
constexpr size_t WS_QM = WS_VTF + (size_t)NTOK * 1024 * 2;
constexpr size_t WS_KN = WS_QM + (size_t)NTOK * 1536 * 2;
constexpr size_t WS_VTM = WS_KN + (size_t)NTOK * 1024 * 2;
constexpr size_t WS_O = WS_VTM + (size_t)NTOK * 1024 * 2;
constexpr size_t WS_END = WS_O + (size_t)NTOK * DM * 2;

#ifndef PHASE_MASK
#define PHASE_MASK 0xffffffffu
#endif
#define PH(n) ((PHASE_MASK >> (n)) & 1u)

struct Params {
    const float *x, *c, *w_ada, *b_ada, *g1pre, *g1post, *w1g, *w1u, *w1d, *gmpre, *gmpost, *w_in, *b_forget, *g_qa, *w_uq, *g_kva, *w_ukv, *w_o,
        *g2pre, *g2post, *w2g, *w2u, *w2d;
    float* out;
    unsigned char* ws;
};

typedef const Params __attribute__((address_space(4)))* KP;
DEVI KP kparams() { KP kp = (KP)__builtin_amdgcn_kernarg_segment_ptr(); asm volatile("" : "+s"(kp)); return kp; }
DEVI unsigned cvt_pk_bf16(float lo, float hi) { unsigned r; asm("v_cvt_pk_bf16_f32 %0, %1, %2" : "=v"(r) : "v"(lo), "v"(hi)); return r; }
DEVI int phase_tid() { int t = threadIdx.x; asm volatile("" : "+v"(t)); return t; }
DEVI float bf2f(unsigned short v) { return __uint_as_float((unsigned)v << 16); }
DEVI float fast_exp2(float x) { return __builtin_amdgcn_exp2f(x); }
DEVI float silu_f(float g) { return g * __builtin_amdgcn_rcpf(1.0f + __expf(-g)); }
DEVI int perm32(int rho) { const int n = rho >> 4, i = rho & 15; return 8 * (i >> 2) + 4 * n + (i & 3); }
DEVI int permcol(int r) { return (r & ~31) + perm32(r & 31); }

struct MapPlain { const float* W; DEVI const float* operator()(int r) const { return W + permcol(r); } };
struct MapUp { const float *Wg, *Wu; DEVI const float* operator()(int r) const { const int t = r >> 8, w = r & 255, half = w >> 7; const uintptr_t mk = (uintptr_t)0 - (uintptr_t)half; const float* base = (const float*)(((uintptr_t)Wg & ~mk) | ((uintptr_t)Wu & mk)); return base + t * 128 + permcol(w & 127); } };
struct MapIn { const float* W;
    DEVI const float* operator()(int r) const {
        const int l = permcol(r);
        int c;
        if (l < 768) c = l;
        else if (l < 1024) { const int j = l - 768, bj = j >> 7, jj = j & 127;
            if (jj < 32) c = 768 + bj * 32 + jj;
            else if (bj == 0 && jj < 40) c = 3904 + jj - 32;
            else c = -1; }
        else if (l < 2048) c = 832 + l - 1024;
        else if (l < 3072) c = 1856 + l - 2048;
        else c = 2880 + l - 3072;
        return c < 0 ? nullptr : W + c;
    } };
struct MapUq { const float* W;
    DEVI const float* operator()(int r) const {
        const int l = permcol(r);
        if (l < 1024) return W + (l >> 7) * 192 + (l & 127);
        const int t = (l - 1024) >> 8, j = (l - 1024) & 255, bj = j >> 7, jj = j & 127, hh = jj >> 5, i = jj & 31;
        return W + (4 * t + hh) * 192 + 128 + bj * 32 + i;
    } };
struct MapUkv { const float* W;
    DEVI const float* operator()(int r) const {
        const int l = permcol(r);
        if (l < 1024) return W + (l >> 7) * 256 + (l & 127);
        return W + ((l - 1024) >> 7) * 256 + 128 + (l & 127);
    } };

template <class Map>
DEVI void conv_weight(const Map& map, bf16_t* __restrict__ Bt, int Nrows, int K, int ldw, const float* __restrict__ rs) {
    extern __shared__ __attribute__((aligned(16))) unsigned char shm[];
    float* tile = (float*)shm;
    const int tid = phase_tid(), nkb = K >> 7, nun = (Nrows >> 6) * nkb;
    for (int u = blockIdx.x; u < nun; u += gridDim.x) {
        const int rb = u / nkb, kb = u - rb * nkb, r0 = rb * 64, k0 = kb * 128;
        const int n = tid & 63, kq = tid >> 6;
        const float* scp = map(r0 + n);
        float v[16];
#pragma unroll
        for (int it = 0; it < 16; ++it) { const int k = k0 + kq + 8 * it; v[it] = scp ? scp[(size_t)k * ldw] : 0.f; }
        if (rs) {
#pragma unroll
            for (int it = 0; it < 16; ++it) v[it] *= rs[k0 + kq + 8 * it];
        }
        __syncthreads();
#pragma unroll
        for (int it = 0; it < 16; ++it) tile[(kq + 8 * it) * 65 + n] = v[it];
        __syncthreads();
        const int rn = tid >> 3, kc = tid & 7;
        unsigned pk[8];
#pragma unroll
        for (int j = 0; j < 8; ++j) pk[j] = cvt_pk_bf16(tile[(kc * 16 + 2 * j) * 65 + rn], tile[(kc * 16 + 2 * j + 1) * 65 + rn]);
        u32x4* dst = (u32x4*)(Bt + (size_t)(r0 + rn) * K + k0 + kc * 16);
        dst[0] = (u32x4){pk[0], pk[1], pk[2], pk[3]};
        dst[1] = (u32x4){pk[4], pk[5], pk[6], pk[7]};
    }
    __syncthreads();
}

DEVI void ada_gemv(const float* __restrict__ w_ada, const float* __restrict__ b_ada, const float* __restrict__ cvec, unsigned char* ws) {
    float* mod = (float*)(ws + WS_MOD);
    const int tid = phase_tid();
    for (int u = blockIdx.x; u < 9 * 32; u += gridDim.x) {
        const int cb = u % 9, kc = u / 9, col = cb * 2048 + tid * 4, k0 = kc * 64;
        f32x4 a0 = {0.f, 0.f, 0.f, 0.f}, a1 = {0.f, 0.f, 0.f, 0.f};
#pragma unroll 8
        for (int k = 0; k < 64; ++k) {
            const f32x4 w = *(const f32x4*)(w_ada + (size_t)(k0 + k) * NMOD + col);
            const float c0 = silu_f(cvec[k0 + k]), c1 = silu_f(cvec[DM + k0 + k]);
            a0 += c0 * w; a1 += c1 * w;
        }
        if (kc == 0) { const f32x4 bb = *(const f32x4*)(b_ada + col); a0 += bb; a1 += bb; }
#pragma unroll
        for (int j = 0; j < 4; ++j) { unsafeAtomicAdd(mod + col + j, a0[j]); unsafeAtomicAdd(mod + NMOD + col + j, a1[j]); }
    }
}

DEVI void rope_table(unsigned char* ws) {
    float* rc = (float*)(ws + WS_ROPEC); float* rsn = (float*)(ws + WS_ROPES);
    for (int idx = blockIdx.x * 512 + phase_tid(); idx < SEQ * 32; idx += gridDim.x * 512) {
        const int pos = idx >> 5, i = idx & 31;
        const float inv = exp2f(-(float)i * (13.287712379549449f / 32.0f));
        const float ang = (float)pos * inv;
        double rev = (double)ang * 0.15915494309189535; rev -= rint(rev);
        rc[idx] = __builtin_amdgcn_cosf((float)rev);
        rsn[idx] = __builtin_amdgcn_sinf((float)rev);
    }
}

template <bool HAS_Y, bool HAS_H>
DEVI void rowpass(const float* xin, float* xout, const bf16_t* __restrict__ Y, const float* __restrict__ ssy, const float* __restrict__ gpost, const float* __restrict__ gate,
                  float coeff, const float* __restrict__ gpre, const float* __restrict__ shift, const float* __restrict__ scale, bf16_t* __restrict__ H) {
    const int tid_ = phase_tid(); const int wid = tid_ >> 6, lane = tid_ & 63;
    for (int row = blockIdx.x * 8 + wid; row < NTOK; row += gridDim.x * 8) {
        const int b = row >> 12;
        int l4 = lane * 4; asm volatile("" : "+v"(l4));
        f32x4 xv[8];
        float rstd_y = 0.f;
        if (HAS_Y) rstd_y = rsqrtf(ssy[row] * (1.0f / DM) + EPS);
        float ss = 0.f;
#pragma unroll
        for (int ch = 0; ch < 8; ++ch) {
            const int col = ch * 256 + l4;
            f32x4 xx = *(const f32x4*)(xin + (size_t)row * DM + col);
            if (HAS_Y) {
                const u32x2 yy = *(const u32x2*)(Y + (size_t)row * DM + col);
                const f32x4 gp = *(const f32x4*)(gpost + col);
                const f32x4 gt = *(const f32x4*)(gate + (size_t)b * NMOD + col);
                f32x4 yv = {__uint_as_float(yy.x << 16), __uint_as_float(yy.x & 0xffff0000u), __uint_as_float(yy.y << 16), __uint_as_float(yy.y & 0xffff0000u)};
                xx += coeff * gt * (yv * rstd_y * gp);
                *(f32x4*)(xout + (size_t)row * DM + col) = xx;
            }
            xv[ch] = xx;
            ss += xx[0] * xx[0] + xx[1] * xx[1] + xx[2] * xx[2] + xx[3] * xx[3];
        }
        if (HAS_H) {
#pragma unroll
            for (int o = 32; o >= 1; o >>= 1) ss += __shfl_xor(ss, o);
            const float rstd = rsqrtf(ss * (1.0f / DM) + EPS);
#pragma unroll
            for (int ch = 0; ch < 8; ++ch) {
                const int col = ch * 256 + l4;
                const f32x4 gp = *(const f32x4*)(gpre + col);
                const f32x4 sc = *(const f32x4*)(scale + (size_t)b * NMOD + col);
                const f32x4 sh = *(const f32x4*)(shift + (size_t)b * NMOD + col);
                const f32x4 hv = (xv[ch] * rstd * gp) * (1.0f + sc) + sh;
                u32x2 o2; o2.x = cvt_pk_bf16(hv[0], hv[1]); o2.y = cvt_pk_bf16(hv[2], hv[3]);
                *(u32x2*)(H + (size_t)row * DM + col) = o2;
            }
        }
    }
}

DEVI int lds_byte(int r, int c) { const int st = (r >> 4) * 2 + (c >> 5), rr = r & 15, cc = c & 31, ob = rr * 64 + cc * 2; return st * 1024 + (ob ^ (((ob >> 9) & 1) << 5)); }
DEVI void stage_rc(int b, int& R, int& C) { const int st = b / 1024, sb = b % 1024, swz = sb ^ (((sb >> 9) & 1) << 5); R = (st >> 1) * 16 + swz / 64; C = (st & 1) * 32 + (swz % 64) / 2; }

DEVI bool next_unit(int i, int nM, int nN, int& pm, int& pn) {
    const int nwg = nM * nN; const long L = (long)i * gridDim.x + blockIdx.x; if (L >= nwg) return false;
    int wgid = (int)L; { const int q = nwg / 8, r = nwg % 8, xcd = wgid % 8, off = wgid / 8; wgid = (xcd < r ? xcd * (q + 1) : r * (q + 1) + (xcd - r) * q) + off; }
    const int nig = 8 * nN, gid = wgid / nig, fm = gid * 8, gsz = (nM - fm) < 8 ? (nM - fm) : 8;
    pm = fm + ((wgid % nig) % gsz); pn = (wgid % nig) / gsz; return true;
}

typedef f32x4 acc_t[2][2][4][2];
#define LAS __attribute__((address_space(3)))

template <class Epi>
DEVI void gemm_phase(const bf16_t* __restrict__ A, const bf16_t* __restrict__ Bt, const int M, const int N, const int K, const Epi& E) {
    extern __shared__ __attribute__((aligned(16))) unsigned char shm[];
    LAS unsigned char* lds = (LAS unsigned char*)shm;
    constexpr int BK = 64, HALF = 128, HTB = HALF * BK * 2;
    const int tid = phase_tid(), wid = __builtin_amdgcn_readfirstlane(tid >> 6), lane = tid & 63, wr = wid >> 2, wc = wid & 3, fr = lane & 15, fq = lane >> 4;
    const int nt = K / BK, nM = M / 256, nN = N / 256;
    unsigned voff[2];
#pragma unroll
    for (int i = 0; i < 2; ++i) { int R, C; stage_rc(tid * 16 + i * 8192, R, C); voff[i] = (unsigned)(R * K + C) * 2u; }
    const size_t kstep = (size_t)(BK * 2);
    const size_t hstep = (size_t)HALF * K * 2;
    const size_t tstep = 2 * hstep;
    const unsigned ldsw = (unsigned)wid * 1024u;
    const int aoff = lds_byte(wr * 64 + fr, fq * 8), boff = lds_byte(wc * 32 + fr, fq * 8);
#define PG8_SA(b, h) (((b) * 2 + (h)) * HTB)
#define PG8_SB(b, h) ((4 + (b) * 2 + (h)) * HTB)
#define PG8_STAGE(bufoff, gbase) do { _Pragma("unroll") for (int _i = 0; _i < 2; ++_i) \
        __builtin_amdgcn_global_load_lds((const unsigned*)((const char*)(gbase) + voff[_i]), (LAS unsigned*)(lds + (bufoff) + ldsw + _i * 8192), 16, 0, 0); } while (0)
#define PG8_LDA(dst, b, h) do { _Pragma("unroll") for (int m = 0; m < 4; ++m) _Pragma("unroll") for (int k = 0; k < 2; ++k) dst[m][k] = *(const LAS bf16x8*)(lds + PG8_SA(b, h) + aoff + m * 2048 + k * 1024); } while (0)
#define PG8_LDB(dst, b, h) do { _Pragma("unroll") for (int n = 0; n < 2; ++n) _Pragma("unroll") for (int k = 0; k < 2; ++k) dst[n][k] = *(const LAS bf16x8*)(lds + PG8_SB(b, h) + boff + n * 2048 + k * 1024); } while (0)
#define PG8_MMA(ai, bj, At_, Bt_) do { __builtin_amdgcn_s_setprio(1); _Pragma("unroll") for (int m = 0; m < 4; ++m) _Pragma("unroll") for (int n = 0; n < 2; ++n) _Pragma("unroll") for (int k = 0; k < 2; ++k) \
        acc[ai][bj][m][n] = __builtin_amdgcn_mfma_f32_16x16x32_bf16(Bt_[n][k], At_[m][k], acc[ai][bj][m][n], 0, 0, 0); __builtin_amdgcn_s_setprio(0); } while (0)
#define PG8_WAIT_V(n) asm volatile("s_waitcnt vmcnt(" #n ")" ::: "memory")
#define PG8_WAIT_L(n) asm volatile("s_waitcnt lgkmcnt(" #n ")" ::: "memory")
#define PG8_BAR __builtin_amdgcn_s_barrier()
#define PG8_SCHED __builtin_amdgcn_sched_barrier(0)
    int cpm, cpn, npm = 0, npn = 0, ui = 0;
    if (!next_unit(0, nM, nN, cpm, cpn)) return;
    acc_t acc;
#pragma unroll
    for (int a = 0; a < 2; ++a)
#pragma unroll
        for (int b = 0; b < 2; ++b)
#pragma unroll
            for (int m = 0; m < 4; ++m)
#pragma unroll
                for (int n = 0; n < 2; ++n) acc[a][b][m][n] = (f32x4){0.f, 0.f, 0.f, 0.f};
    bf16x8 At[4][2], B0[2][2], B1[2][2];
    const char* cA = (const char*)A + (size_t)cpm * tstep; const char* cB = (const char*)Bt + (size_t)cpn * tstep;
    PG8_STAGE(PG8_SB(0, 0), cB); PG8_STAGE(PG8_SA(0, 0), cA); PG8_STAGE(PG8_SB(0, 1), cB + hstep); PG8_STAGE(PG8_SA(0, 1), cA + hstep);
    if (wr == 1) PG8_BAR;
    PG8_WAIT_V(4); PG8_BAR;
    PG8_STAGE(PG8_SB(1, 0), cB + kstep); PG8_STAGE(PG8_SA(1, 0), cA + kstep); PG8_STAGE(PG8_SB(1, 1), cB + hstep + kstep);
    PG8_WAIT_V(6); PG8_BAR;
    for (;;) {
        const bool has_next = next_unit(ui + 1, nM, nN, npm, npn);
        const char* nA = has_next ? (const char*)A + (size_t)npm * tstep : cA; const char* nB = has_next ? (const char*)Bt + (size_t)npn * tstep : cB;
        for (int t = 0; t < nt; t += 2) {
            const bool last = (t == nt - 2);
            const char* a1 = cA + (size_t)(t + 1) * kstep;
            const char* a2 = last ? nA : cA + (size_t)(t + 2) * kstep; const char* b2 = last ? nB : cB + (size_t)(t + 2) * kstep;
            const char* a3 = a2 + kstep; const char* b3 = b2 + kstep;
            PG8_LDB(B0, 0, 0); PG8_SCHED; PG8_LDA(At, 0, 0); PG8_STAGE(PG8_SA(1, 1), a1 + hstep);
            PG8_WAIT_L(8); PG8_BAR; PG8_WAIT_L(0); PG8_MMA(0, 0, At, B0); PG8_BAR; PG8_SCHED;
            PG8_LDB(B1, 0, 1); PG8_STAGE(PG8_SB(0, 0), b2);
            PG8_BAR; PG8_WAIT_L(0); PG8_MMA(0, 1, At, B1); PG8_BAR;
            PG8_LDA(At, 0, 1); PG8_STAGE(PG8_SA(0, 0), a2);
            PG8_BAR; PG8_WAIT_L(0); PG8_MMA(1, 0, At, B0); PG8_BAR; PG8_SCHED;
            PG8_STAGE(PG8_SB(0, 1), b2 + hstep);
            PG8_WAIT_V(6); PG8_BAR; PG8_MMA(1, 1, At, B1); PG8_BAR;
            PG8_LDB(B0, 1, 0); PG8_SCHED; PG8_LDA(At, 1, 0); PG8_STAGE(PG8_SA(0, 1), a2 + hstep);
            PG8_WAIT_L(8); PG8_BAR; PG8_WAIT_L(0); PG8_MMA(0, 0, At, B0); PG8_BAR; PG8_SCHED;
            PG8_LDB(B1, 1, 1); PG8_STAGE(PG8_SB(1, 0), b3);
            PG8_BAR; PG8_WAIT_L(0); PG8_MMA(0, 1, At, B1); PG8_BAR;
            PG8_LDA(At, 1, 1); PG8_STAGE(PG8_SA(1, 0), a3);
            PG8_BAR; PG8_WAIT_L(0); PG8_MMA(1, 0, At, B0); PG8_BAR; PG8_SCHED;
            PG8_STAGE(PG8_SB(1, 1), b3 + hstep);
            PG8_WAIT_V(6); PG8_BAR; PG8_MMA(1, 1, At, B1); PG8_BAR;
        }
        E(acc, cpm, cpn, wr, wc, fr, fq);
        if (!has_next) break;
#pragma unroll
        for (int a = 0; a < 2; ++a)
#pragma unroll
            for (int b = 0; b < 2; ++b)
#pragma unroll
                for (int m = 0; m < 4; ++m)
#pragma unroll
                    for (int n = 0; n < 2; ++n) acc[a][b][m][n] = (f32x4){0.f, 0.f, 0.f, 0.f};
        cpm = npm; cpn = npn; cA = nA; cB = nB; ++ui;
    }
    PG8_WAIT_V(0);
    if (wr == 0) PG8_BAR;
    PG8_BAR;
#undef PG8_SA
#undef PG8_SB
#undef PG8_STAGE
#undef PG8_LDA
#undef PG8_LDB
#undef PG8_MMA
}

struct EpiSwiglu {
    bf16_t* U;
    DEVI void operator()(const acc_t& acc, int pm, int pn, int wr, int wc, int fr, int fq) const {
#pragma unroll
        for (int ai = 0; ai < 2; ++ai)
#pragma unroll
            for (int m = 0; m < 4; ++m) {
                const int row = pm * 256 + ai * 128 + wr * 64 + m * 16 + fr;
                const f32x4 g0 = acc[ai][0][m][0], g1 = acc[ai][0][m][1], u0 = acc[ai][1][m][0], u1 = acc[ai][1][m][1];
                u32x4 w;
                w.x = cvt_pk_bf16(silu_f(g0[0]) * u0[0], silu_f(g0[1]) * u0[1]);
                w.y = cvt_pk_bf16(silu_f(g0[2]) * u0[2], silu_f(g0[3]) * u0[3]);
                w.z = cvt_pk_bf16(silu_f(g1[0]) * u1[0], silu_f(g1[1]) * u1[1]);
                w.w = cvt_pk_bf16(silu_f(g1[2]) * u1[2], silu_f(g1[3]) * u1[3]);
                *(u32x4*)(U + (size_t)row * DFF + pn * 128 + wc * 32 + 8 * fq) = w;
            }
    }
};
DEVI u32x4 pack8(const f32x4 a, const f32x4 b, float s) {
    u32x4 w; w.x = cvt_pk_bf16(a[0] * s, a[1] * s); w.y = cvt_pk_bf16(a[2] * s, a[3] * s); w.z = cvt_pk_bf16(b[0] * s, b[1] * s); w.w = cvt_pk_bf16(b[2] * s, b[3] * s); return w;
}
DEVI float sq8(const f32x4 a, const f32x4 b) { return a[0] * a[0] + a[1] * a[1] + a[2] * a[2] + a[3] * a[3] + b[0] * b[0] + b[1] * b[1] + b[2] * b[2] + b[3] * b[3]; }
struct EpiY {
    bf16_t* Y; int ldy; float* ss;
    DEVI void operator()(const acc_t& acc, int pm, int pn, int wr, int wc, int fr, int fq) const {
#pragma unroll
        for (int ai = 0; ai < 2; ++ai)
#pragma unroll
            for (int m = 0; m < 4; ++m) {
                const int row = pm * 256 + ai * 128 + wr * 64 + m * 16 + fr;
                float s = 0.f;
#pragma unroll
                for (int bj = 0; bj < 2; ++bj) {
                    s += sq8(acc[ai][bj][m][0], acc[ai][bj][m][1]);
                    *(u32x4*)(Y + (size_t)row * ldy + pn * 256 + bj * 128 + wc * 32 + 8 * fq) = pack8(acc[ai][bj][m][0], acc[ai][bj][m][1], 1.0f);
                }
                s += __shfl_xor(s, 16); s += __shfl_xor(s, 32);
                if (fq == 0) unsafeAtomicAdd(ss + row, s);
            }
    }
};
DEVI void store_vt(bf16_t* __restrict__ Vt, int row, int head, int d0, const f32x4 a, const f32x4 b, float s) {
    const int bb = row >> 12, sp = row & 4095;
    bf16_t* base = Vt + ((size_t)(bb * 8 + head) * 128 + d0) * SEQ + sp;
    const u32x4 w = pack8(a, b, s);
    base[0 * SEQ] = (bf16_t)(w.x & 0xffff); base[1 * SEQ] = (bf16_t)(w.x >> 16);
    base[2 * SEQ] = (bf16_t)(w.y & 0xffff); base[3 * SEQ] = (bf16_t)(w.y >> 16);
    base[4 * SEQ] = (bf16_t)(w.z & 0xffff); base[5 * SEQ] = (bf16_t)(w.z >> 16);
    base[6 * SEQ] = (bf16_t)(w.w & 0xffff); base[7 * SEQ] = (bf16_t)(w.w >> 16);
}
DEVI float log_sigmoid_f(float x) { return x >= 0.f ? -log1pf(expf(-x)) : x - log1pf(expf(x)); }
struct EpiIn {
    bf16_t *QA, *KVA, *KR, *FQ, *FK, *VTF; float *ssq, *sskv, *logf; const float *ropec, *ropes, *b_forget;
    DEVI void operator()(const acc_t& acc, int pm, int pn, int wr, int wc, int fr, int fq) const {
        const float qs = LOG2E * 0.08838834764831845f;
#pragma unroll
        for (int ai = 0; ai < 2; ++ai)
#pragma unroll
            for (int m = 0; m < 4; ++m) {
                const int row = pm * 256 + ai * 128 + wr * 64 + m * 16 + fr;
                if (pn < 3) {
                    bf16_t* dst = pn < 2 ? QA + (size_t)row * 512 + pn * 256 : KVA + (size_t)row * 256;
                    float s = 0.f;
#pragma unroll
                    for (int bj = 0; bj < 2; ++bj) {
                        s += sq8(acc[ai][bj][m][0], acc[ai][bj][m][1]);
                        *(u32x4*)(dst + bj * 128 + wc * 32 + 8 * fq) = pack8(acc[ai][bj][m][0], acc[ai][bj][m][1], 1.0f);
                    }
                    s += __shfl_xor(s, 16); s += __shfl_xor(s, 32);
                    if (fq == 0) unsafeAtomicAdd((pn < 2 ? ssq : sskv) + row, s);
                } else if (pn == 3) {
                    if (wc == 0) {
                        const int pos = row & 4095;
#pragma unroll
                        for (int n = 0; n < 2; ++n) {
                            const int i0 = 8 * fq + 4 * n;
                            const f32x4 cs = *(const f32x4*)(ropec + pos * 32 + i0), sn = *(const f32x4*)(ropes + pos * 32 + i0);
                            const f32x4 x1 = acc[ai][0][m][n], x2 = acc[ai][1][m][n];
                            const f32x4 o1 = x1 * cs - x2 * sn, o2 = x1 * sn + x2 * cs;
                            u32x2 w1, w2; w1.x = cvt_pk_bf16(o1[0], o1[1]); w1.y = cvt_pk_bf16(o1[2], o1[3]); w2.x = cvt_pk_bf16(o2[0], o2[1]); w2.y = cvt_pk_bf16(o2[2], o2[3]);
                            *(u32x2*)(KR + (size_t)row * 64 + i0) = w1;
                            *(u32x2*)(KR + (size_t)row * 64 + 32 + i0) = w2;
                        }
                    } else if (wc == 1 && fq == 0) {
#pragma unroll
                        for (int n = 0; n < 2; ++n) {
                            f32x4 lf;
#pragma unroll
                            for (int j = 0; j < 4; ++j) lf[j] = log_sigmoid_f(acc[ai][0][m][n][j] + b_forget[4 * n + j]);
                            *(f32x4*)(logf + (size_t)row * 8 + 4 * n) = lf;
                        }
                    }
                } else if (pn < 12) {
                    bf16_t* dst = (pn < 8 ? FQ : FK) + (size_t)row * 1024 + ((pn - 4) & 3) * 256;
                    const float sc = pn < 8 ? qs : 1.0f;
#pragma unroll
                    for (int bj = 0; bj < 2; ++bj) *(u32x4*)(dst + bj * 128 + wc * 32 + 8 * fq) = pack8(acc[ai][bj][m][0], acc[ai][bj][m][1], sc);
                } else {
#pragma unroll
                    for (int bj = 0; bj < 2; ++bj) store_vt(VTF, row, 2 * (pn - 12) + bj, wc * 32 + 8 * fq, acc[ai][bj][m][0], acc[ai][bj][m][1], 1.0f);
                }
            }
    }
};
struct EpiQ {
    bf16_t* QM; const float *ssq, *ropec, *ropes;
    DEVI void operator()(const acc_t& acc, int pm, int pn, int wr, int wc, int fr, int fq) const {
        const float qs = LOG2E * 0.07216878364870323f;
#pragma unroll
        for (int ai = 0; ai < 2; ++ai)
#pragma unroll
            for (int m = 0; m < 4; ++m) {
                const int row = pm * 256 + ai * 128 + wr * 64 + m * 16 + fr;
                const float rstd = rsqrtf(ssq[row] * (1.0f / 512.0f) + EPS) * qs;
                if (pn < 4) {
#pragma unroll
                    for (int bj = 0; bj < 2; ++bj)
                        *(u32x4*)(QM + (size_t)row * 1536 + (2 * pn + bj) * 192 + wc * 32 + 8 * fq) = pack8(acc[ai][bj][m][0], acc[ai][bj][m][1], rstd);
                } else {
                    const int head = 4 * (pn - 4) + wc, pos = row & 4095;
#pragma unroll
                    for (int n = 0; n < 2; ++n) {
                        const int i0 = 8 * fq + 4 * n;
                        const f32x4 cs = *(const f32x4*)(ropec + pos * 32 + i0), sn = *(const f32x4*)(ropes + pos * 32 + i0);
                        const f32x4 x1 = acc[ai][0][m][n] * rstd, x2 = acc[ai][1][m][n] * rstd;
                        const f32x4 o1 = x1 * cs - x2 * sn, o2 = x1 * sn + x2 * cs;
                        u32x2 w1, w2; w1.x = cvt_pk_bf16(o1[0], o1[1]); w1.y = cvt_pk_bf16(o1[2], o1[3]); w2.x = cvt_pk_bf16(o2[0], o2[1]); w2.y = cvt_pk_bf16(o2[2], o2[3]);
                        *(u32x2*)(QM + (size_t)row * 1536 + head * 192 + 128 + i0) = w1;
                        *(u32x2*)(QM + (size_t)row * 1536 + head * 192 + 160 + i0) = w2;
                    }
                }
            }
    }
};
struct EpiKV {
    bf16_t *KN, *VTM; const float* sskv;
    DEVI void operator()(const acc_t& acc, int pm, int pn, int wr, int wc, int fr, int fq) const {
#pragma unroll
        for (int ai = 0; ai < 2; ++ai)
#pragma unroll
            for (int m = 0; m < 4; ++m) {
                const int row = pm * 256 + ai * 128 + wr * 64 + m * 16 + fr;
                const float rstd = rsqrtf(sskv[row] * (1.0f / 256.0f) + EPS);
                if (pn < 4) {
#pragma unroll
                    for (int bj = 0; bj < 2; ++bj)
                        *(u32x4*)(KN + (size_t)row * 1024 + pn * 256 + bj * 128 + wc * 32 + 8 * fq) = pack8(acc[ai][bj][m][0], acc[ai][bj][m][1], rstd);
                } else {
#pragma unroll
                    for (int bj = 0; bj < 2; ++bj) store_vt(VTM, row, 2 * (pn - 4) + bj, wc * 32 + 8 * fq, acc[ai][bj][m][0], acc[ai][bj][m][1], rstd);
                }
            }
    }
};

DEVI void cumsum_unit(const float* __restrict__ logf, float* __restrict__ cum, int bh) {
    const int lane = phase_tid() & 63, b = bh >> 3, h = bh & 7;
    const float* src = logf + ((size_t)b * SEQ + lane * 64) * 8 + h;
    float s = 0.f;
    for (int i = 0; i < 64; ++i) s += src[i * 8];
    float incl = s;
#pragma unroll
    for (int o = 1; o < 64; o <<= 1) { const float t = __shfl_up(incl, o); if (lane >= o) incl += t; }
    float run = incl - s;
    float* dst = cum + (size_t)bh * SEQ + lane * 64;
    for (int i = 0; i < 64; ++i) { run += src[i * 8]; dst[i] = run * LOG2E; }
}

template <int DQK, bool FOX>
DEVI void attn_item(const bf16_t* __restrict__ Q, int ldq, const bf16_t* __restrict__ K1, const bf16_t* __restrict__ K2, const bf16_t* __restrict__ Vt,
                    const float* __restrict__ cum, bf16_t* __restrict__ O, int qb) {
    extern __shared__ __attribute__((aligned(16))) unsigned char shm[];
    constexpr int KSTR = DQK * 2 + 16, VSTR = 144, CPR = DQK / 8, NKC = 64 * CPR / 512, KBUF = 64 * KSTR, VBUF = 128 * VSTR, NKS = DQK / 16;
    unsigned char* Kb = shm; unsigned char* Vb = shm + 2 * KBUF; float* Cb = (float*)(shm + 2 * KBUF + 2 * VBUF);
    const int tid = phase_tid(), wid = tid >> 6, lane = tid & 63, n = lane & 31, g = lane >> 5;
    const int Q0 = qb * 256, q0w = Q0 + wid * 32;
    const int ntile = Q0 / 64 + 4, mytiles = q0w / 64 + 1;
    const int pin = (n & 0x13) | ((n & 4) << 1) | ((n & 8) >> 1);

    bf16x8 qf[NKS];
#pragma unroll
    for (int ks = 0; ks < NKS; ++ks) qf[ks] = *(const bf16x8*)(Q + (size_t)(q0w + n) * ldq + ks * 16 + g * 8);
    float cq = 0.f; if (FOX) cq = cum[q0w + n];
    f32x16 o[4];
#pragma unroll
    for (int mt = 0; mt < 4; ++mt)
#pragma unroll
        for (int i = 0; i < 16; ++i) o[mt][i] = 0.f;
    float mrun = -INFINITY, lrun = 0.f;

    u32x4 kreg[NKC], vreg[2]; float creg = 0.f;
#define GLOAD(kt_) do { const int k0_ = (kt_) * 64; \
    _Pragma("unroll") for (int i_ = 0; i_ < NKC; ++i_) { const int c_ = tid + i_ * 512, row_ = c_ / CPR, j_ = c_ - row_ * CPR; \
        const bf16_t* src_ = (!FOX && j_ >= 16) ? K2 + (size_t)(k0_ + row_) * 64 + (j_ - 16) * 8 : K1 + (size_t)(k0_ + row_) * 1024 + j_ * 8; \
        kreg[i_] = *(const u32x4*)src_; } \
    _Pragma("unroll") for (int i_ = 0; i_ < 2; ++i_) { const int c_ = tid + i_ * 512, d_ = c_ >> 3, j_ = c_ & 7; vreg[i_] = *(const u32x4*)(Vt + (size_t)d_ * SEQ + k0_ + j_ * 8); } \
    if (FOX && tid < 64) creg = cum[k0_ + tid]; } while (0)
#define LSTORE(buf_) do { \
    _Pragma("unroll") for (int i_ = 0; i_ < NKC; ++i_) { const int c_ = tid + i_ * 512, row_ = c_ / CPR, j_ = c_ - row_ * CPR; *(u32x4*)(Kb + (buf_) * KBUF + row_ * KSTR + j_ * 16) = kreg[i_]; } \
    _Pragma("unroll") for (int i_ = 0; i_ < 2; ++i_) { const int c_ = tid + i_ * 512, d_ = c_ >> 3, j_ = c_ & 7; *(u32x4*)(Vb + (buf_) * VBUF + d_ * VSTR + j_ * 16) = vreg[i_]; } \
    if (FOX && tid < 64) Cb[(buf_) * 64 + tid] = creg; } while (0)

    __syncthreads();
    GLOAD(0); LSTORE(0); __syncthreads();
    for (int kt = 0; kt < ntile; ++kt) {
        const int buf = kt & 1;
        if (kt + 1 < ntile) GLOAD(kt + 1);
        if (kt < mytiles) {
            f32x16 st[2];
#pragma unroll
            for (int sub = 0; sub < 2; ++sub) {
#pragma unroll
                for (int i = 0; i < 16; ++i) st[sub][i] = 0.f;
                const unsigned char* kb = Kb + buf * KBUF + (sub * 32 + pin) * KSTR + g * 16;
#pragma unroll
                for (int ks = 0; ks < NKS; ++ks) st[sub] = __builtin_amdgcn_mfma_f32_32x32x16_bf16(*(const bf16x8*)(kb + ks * 32), qf[ks], st[sub], 0, 0, 0);
            }
            if (FOX) {
                const bool diag = (kt == mytiles - 1);
                const int tq = q0w + n;
#pragma unroll
                for (int sub = 0; sub < 2; ++sub)
#pragma unroll
                    for (int half = 0; half < 2; ++half) {
                        const int kofs = sub * 32 + half * 16 + 8 * g;
                        const f32x4 c0 = *(const f32x4*)(Cb + buf * 64 + kofs), c1 = *(const f32x4*)(Cb + buf * 64 + kofs + 4);
#pragma unroll
                        for (int jj = 0; jj < 8; ++jj) {
                            const float ck = jj < 4 ? c0[jj & 3] : c1[jj & 3];
                            float v = st[sub][half * 8 + jj] + (cq - ck);
                            if (diag && (kt * 64 + kofs + jj > tq)) v = -INFINITY;
                            st[sub][half * 8 + jj] = v;
                        }
                    }
            }
            float mx = st[0][0];
#pragma unroll
            for (int i = 1; i < 16; ++i) mx = fmaxf(mx, st[0][i]);
#pragma unroll
            for (int i = 0; i < 16; ++i) mx = fmaxf(mx, st[1][i]);
            mx = fmaxf(mx, __shfl_xor(mx, 32));
            const float mnew = fmaxf(mrun, mx);
            const float alpha = fast_exp2(mrun - mnew);
            mrun = mnew;
            float psum = 0.f;
#pragma unroll
            for (int sub = 0; sub < 2; ++sub)
#pragma unroll
                for (int i = 0; i < 16; ++i) { const float pv = fast_exp2(st[sub][i] - mnew); st[sub][i] = pv; psum += pv; }
            lrun = lrun * alpha + psum;
#pragma unroll
            for (int mt = 0; mt < 4; ++mt)
#pragma unroll
                for (int i = 0; i < 16; ++i) o[mt][i] *= alpha;
            bf16x8 pf[2][2];
#pragma unroll
            for (int sub = 0; sub < 2; ++sub)
#pragma unroll
                for (int half = 0; half < 2; ++half) {
                    u32x4 w;
                    w.x = cvt_pk_bf16(st[sub][half * 8 + 0], st[sub][half * 8 + 1]); w.y = cvt_pk_bf16(st[sub][half * 8 + 2], st[sub][half * 8 + 3]);
                    w.z = cvt_pk_bf16(st[sub][half * 8 + 4], st[sub][half * 8 + 5]); w.w = cvt_pk_bf16(st[sub][half * 8 + 6], st[sub][half * 8 + 7]);
                    pf[sub][half] = __builtin_bit_cast(bf16x8, w);
                }
#pragma unroll
            for (int mt = 0; mt < 4; ++mt) {
                const unsigned char* vb = Vb + buf * VBUF + (mt * 32 + n) * VSTR + g * 16;
#pragma unroll
                for (int sub = 0; sub < 2; ++sub)
#pragma unroll
                    for (int half = 0; half < 2; ++half)
                        o[mt] = __builtin_amdgcn_mfma_f32_32x32x16_bf16(*(const bf16x8*)(vb + (sub * 32 + half * 16) * 2), pf[sub][half], o[mt], 0, 0, 0);
            }
        }
        if (kt + 1 < ntile) LSTORE(buf ^ 1);
        __syncthreads();
    }
    const float ltot = lrun + __shfl_xor(lrun, 32);
    const float inv = 1.0f / ltot;
    bf16_t* orow = O + (size_t)(q0w + n) * DM;
#pragma unroll
    for (int mt = 0; mt < 4; ++mt)
#pragma unroll
        for (int q4 = 0; q4 < 4; ++q4) {
            u32x2 w; w.x = cvt_pk_bf16(o[mt][4 * q4 + 0] * inv, o[mt][4 * q4 + 1] * inv); w.y = cvt_pk_bf16(o[mt][4 * q4 + 2] * inv, o[mt][4 * q4 + 3] * inv);
            *(u32x2*)(orow + mt * 32 + 8 * q4 + 4 * g) = w;
        }
#undef GLOAD
#undef LSTORE
}

#define WSP(T, off) ((T*)(ws + (off)))
__global__ void __launch_bounds__(512) mega(Params p_unused) {
    cg::grid_group grid = cg::this_grid();
    if (PH(0)) {
        KP kp = kparams(); unsigned char* ws = kp->ws;
        ada_gemv(kp->w_ada, kp->b_ada, kp->c, ws);
        rope_table(ws);
        conv_weight(MapUp{kp->w1g, kp->w1u}, WSP(bf16_t, WS_BT1U), 2 * DFF, DM, DFF, nullptr);
        conv_weight(MapPlain{kp->w1d}, WSP(bf16_t, WS_BT1D), DM, DFF, DM, nullptr);
        conv_weight(MapIn{kp->w_in}, WSP(bf16_t, WS_BTIN), 4096, DM, 3912, nullptr);
        conv_weight(MapUq{kp->w_uq}, WSP(bf16_t, WS_BTUQ), 1536, 512, 1536, kp->g_qa);
        conv_weight(MapUkv{kp->w_ukv}, WSP(bf16_t, WS_BTUKV), 2048, 256, 2048, kp->g_kva);
        conv_weight(MapPlain{kp->w_o}, WSP(bf16_t, WS_BTO), DM, DM, DM, nullptr);
        conv_weight(MapUp{kp->w2g, kp->w2u}, WSP(bf16_t, WS_BT2U), 2 * DFF, DM, DFF, nullptr);
        conv_weight(MapPlain{kp->w2d}, WSP(bf16_t, WS_BT2D), DM, DFF, DM, nullptr);
    }
    grid.sync();
    if (PH(1)) { KP kp = kparams(); unsigned char* ws = kp->ws; const float* mod = WSP(float, WS_MOD);
        rowpass<false, true>(kp->x, nullptr, nullptr, nullptr, nullptr, nullptr, 0.f, kp->g1pre, mod + 0 * DM, mod + 1 * DM, WSP(bf16_t, WS_H)); }
    grid.sync();
    if (PH(2)) { KP kp = kparams(); unsigned char* ws = kp->ws;
        gemm_phase(WSP(bf16_t, WS_H), WSP(bf16_t, WS_BT1U), NTOK, 2 * DFF, DM, EpiSwiglu{WSP(bf16_t, WS_U)}); }
    grid.sync();
    if (PH(3)) { KP kp = kparams(); unsigned char* ws = kp->ws;
        gemm_phase(WSP(bf16_t, WS_U), WSP(bf16_t, WS_BT1D), NTOK, DM, DFF, EpiY{WSP(bf16_t, WS_Y), DM, WSP(float, WS_SS) + 0 * NTOK}); }
    grid.sync();
    if (PH(4)) { KP kp = kparams(); unsigned char* ws = kp->ws; const float* mod = WSP(float, WS_MOD);
        rowpass<true, true>(kp->x, kp->out, WSP(bf16_t, WS_Y), WSP(float, WS_SS) + 0 * NTOK, kp->g1post, mod + 2 * DM, 0.5f, kp->gmpre, mod + 3 * DM, mod + 4 * DM, WSP(bf16_t, WS_H)); }
    grid.sync();
    if (PH(5)) { KP kp = kparams(); unsigned char* ws = kp->ws;
        gemm_phase(WSP(bf16_t, WS_H), WSP(bf16_t, WS_BTIN), NTOK, 4096, DM,
                   EpiIn{WSP(bf16_t, WS_QA), WSP(bf16_t, WS_KVA), WSP(bf16_t, WS_KR), WSP(bf16_t, WS_FQ), WSP(bf16_t, WS_FK), WSP(bf16_t, WS_VTF), WSP(float, WS_SS) + 1 * NTOK,
                         WSP(float, WS_SS) + 2 * NTOK, WSP(float, WS_LOGF), WSP(float, WS_ROPEC), WSP(float, WS_ROPES), kp->b_forget}); }
    grid.sync();
    if (PH(6)) { KP kp = kparams(); unsigned char* ws = kp->ws;
        if ((phase_tid() >> 6) == 0) for (int bh = blockIdx.x; bh < 16; bh += gridDim.x) cumsum_unit(WSP(float, WS_LOGF), WSP(float, WS_CUM), bh);
        gemm_phase(WSP(bf16_t, WS_QA), WSP(bf16_t, WS_BTUQ), NTOK, 1536, 512, EpiQ{WSP(bf16_t, WS_QM), WSP(float, WS_SS) + 1 * NTOK, WSP(float, WS_ROPEC), WSP(float, WS_ROPES)}); }
    if (PH(7)) { KP kp = kparams(); unsigned char* ws = kp->ws;
        gemm_phase(WSP(bf16_t, WS_KVA), WSP(bf16_t, WS_BTUKV), NTOK, 2048, 256, EpiKV{WSP(bf16_t, WS_KN), WSP(bf16_t, WS_VTM), WSP(float, WS_SS) + 2 * NTOK}); }
    grid.sync();
    for (int it = blockIdx.x; it < 256; it += gridDim.x) {
        const int bh = it >> 4, b = bh >> 3, h = bh & 7, qb = it & 15;
        if (PH(8)) { KP kp = kparams(); unsigned char* ws = kp->ws;
            attn_item<192, false>(WSP(bf16_t, WS_QM) + (size_t)b * SEQ * 1536 + h * 192, 1536, WSP(bf16_t, WS_KN) + (size_t)b * SEQ * 1024 + h * 128, WSP(bf16_t, WS_KR) + (size_t)b * SEQ * 64,
                                  WSP(bf16_t, WS_VTM) + (size_t)bh * 128 * SEQ, nullptr, WSP(bf16_t, WS_O) + (size_t)b * SEQ * DM + h * 128, qb); }
        if (PH(9)) { KP kp = kparams(); unsigned char* ws = kp->ws;
            attn_item<128, true>(WSP(bf16_t, WS_FQ) + (size_t)b * SEQ * 1024 + h * 128, 1024, WSP(bf16_t, WS_FK) + (size_t)b * SEQ * 1024 + h * 128, nullptr,
                                 WSP(bf16_t, WS_VTF) + (size_t)bh * 128 * SEQ, WSP(float, WS_CUM) + (size_t)bh * SEQ, WSP(bf16_t, WS_O) + (size_t)b * SEQ * DM + 1024 + h * 128, 15 - qb); }
    }
    grid.sync();
    if (PH(10)) { KP kp = kparams(); unsigned char* ws = kp->ws;
        gemm_phase(WSP(bf16_t, WS_O), WSP(bf16_t, WS_BTO), NTOK, DM, DM, EpiY{WSP(bf16_t, WS_Y), DM, WSP(float, WS_SS) + 3 * NTOK}); }
    grid.sync();
    if (PH(11)) { KP kp = kparams(); unsigned char* ws = kp->ws; const float* mod = WSP(float, WS_MOD);
        rowpass<true, true>(kp->out, kp->out, WSP(bf16_t, WS_Y), WSP(float, WS_SS) + 3 * NTOK, kp->gmpost, mod + 5 * DM, 1.0f, kp->g2pre, mod + 6 * DM, mod + 7 * DM, WSP(bf16_t, WS_H)); }
    grid.sync();
    if (PH(12)) { KP kp = kparams(); unsigned char* ws = kp->ws;
        gemm_phase(WSP(bf16_t, WS_H), WSP(bf16_t, WS_BT2U), NTOK, 2 * DFF, DM, EpiSwiglu{WSP(bf16_t, WS_U)}); }
    grid.sync();
    if (PH(13)) { KP kp = kparams(); unsigned char* ws = kp->ws;
        gemm_phase(WSP(bf16_t, WS_U), WSP(bf16_t, WS_BT2D), NTOK, DM, DFF, EpiY{WSP(bf16_t, WS_Y), DM, WSP(float, WS_SS) + 4 * NTOK}); }
    grid.sync();
    if (PH(14)) { KP kp = kparams(); unsigned char* ws = kp->ws; const float* mod = WSP(float, WS_MOD);
        rowpass<true, false>(kp->out, kp->out, WSP(bf16_t, WS_Y), WSP(float, WS_SS) + 4 * NTOK, kp->g2post, mod + 8 * DM, 0.5f, nullptr, nullptr, nullptr, nullptr); }
}

extern "C" void kernel_launch(void* const* d_in, const int* in_sizes, int n_in, void* d_out, int out_size, void* d_ws, size_t ws_size, hipStream_t stream) {
    static int grid_blocks = 0;
    if (!grid_blocks) {
        int dev = 0, cus = 0, per_cu = 0;
        hipGetDevice(&dev);
        hipDeviceGetAttribute(&cus, hipDeviceAttributeMultiprocessorCount, dev);
        hipFuncSetAttribute((const void*)mega, hipFuncAttributeMaxDynamicSharedMemorySize, LDS_BYTES);
        hipOccupancyMaxActiveBlocksPerMultiprocessor(&per_cu, mega, 512, LDS_BYTES);
        if (per_cu < 1) per_cu = 1;
        if (per_cu > 1) per_cu = 1;
        grid_blocks = cus * per_cu;
        grid_blocks &= ~7;
    }
    if (ws_size < WS_END) { fprintf(stderr, "workspace too small\n"); return; }
    Params p{};
    const float** pf = (const float**)&p;
    for (int i = 0; i < 23; ++i) pf[i] = (const float*)d_in[i];
    p.out = (float*)d_out;
    p.ws = (unsigned char*)d_ws;
    hipMemsetAsync(d_ws, 0, WS_ZERO_END, stream);
    void* args[] = {&p};
    hipError_t e = hipLaunchCooperativeKernel((void*)mega, dim3(grid_blocks), dim3(512), args, LDS_BYTES, stream);
    if (e != hipSuccess) fprintf(stderr, "cooperative launch failed: %s (grid %d)\n", hipGetErrorString(e), grid_blocks);
}
```

```cpp
#include <hip/hip_runtime.h>
#include <hip/hip_cooperative_groups.h>
#include <stdint.h>
#include <stdio.h>
namespace cg = cooperative_groups;

#define DEVI __device__ __forceinline__
typedef unsigned short bf16_t;
typedef short bf16x8 __attribute__((ext_vector_type(8)));
typedef float f32x4 __attribute__((ext_vector_type(4)));
typedef float f32x16 __attribute__((ext_vector_type(16)));
typedef unsigned u32x4 __attribute__((ext_vector_type(4)));
typedef unsigned u32x2 __attribute__((ext_vector_type(2)));

constexpr int DM = 2048, SEQ = 4096, NTOK = 8192, DFF = 5632, NMOD = 9 * DM;
constexpr float EPS = 1e-6f;
constexpr float LOG2E = 1.4426950408889634f;
constexpr int LDS_MAIN = 131072;
constexpr int LDS_VT = LDS_MAIN + 256;
constexpr int LDS_BYTES = LDS_VT + 8 * 2560;

constexpr size_t WS_MOD = 0;
constexpr size_t WS_SS = WS_MOD + (size_t)2 * NMOD * 4;
constexpr size_t WS_BAR = WS_SS + (size_t)8 * NTOK * 4;
constexpr size_t WS_CNT = WS_BAR + 14336;
constexpr size_t WS_FLAG = WS_CNT + (size_t)96 * 256;
constexpr size_t WS_ZERO_END = WS_FLAG + (size_t)256 * 64;
constexpr size_t WS_ROPEC = WS_ZERO_END;
constexpr size_t WS_ROPES = WS_ROPEC + (size_t)SEQ * 32 * 4;
constexpr size_t WS_CUM = WS_ROPES + (size_t)SEQ * 32 * 4;
constexpr size_t WS_LOGF = WS_CUM + (size_t)16 * SEQ * 4;
constexpr size_t WS_BT1U = WS_LOGF + (size_t)NTOK * 8 * 4;
constexpr size_t WS_BT1D = WS_BT1U + (size_t)2 * DFF * DM * 2;
constexpr size_t WS_BT2U = WS_BT1D + (size_t)DM * DFF * 2;
constexpr size_t WS_BT2D = WS_BT2U + (size_t)2 * DFF * DM * 2;
constexpr size_t WS_BTIN = WS_BT2D + (size_t)DM * DFF * 2;
constexpr size_t WS_BTUQ = WS_BTIN + (size_t)4096 * DM * 2;
constexpr size_t WS_BTUKV = WS_BTUQ + (size_t)1536 * 512 * 2;
constexpr size_t WS_BTO = WS_BTUKV + (size_t)2048 * 256 * 2;
constexpr size_t WS_H = WS_BTO + (size_t)DM * DM * 2;
constexpr size_t WS_U = WS_H + (size_t)NTOK * DM * 2;
constexpr size_t WS_Y = WS_U + (size_t)NTOK * DFF * 2;
constexpr size_t WS_QA = WS_Y + (size_t)NTOK * DM * 2;
constexpr size_t WS_KVA = WS_QA + (size_t)NTOK * 512 * 2;
constexpr size_t WS_KR = WS_KVA + (size_t)NTOK * 256 * 2;
constexpr size_t WS_FQ = WS_KR + (size_t)NTOK * 64 * 2;
constexpr size_t WS_FK = WS_FQ + (size_t)NTOK * 1024 * 2;
constexpr size_t WS_VTF = WS_FK + (size_t)NTOK * 1024 * 2;
constexpr size_t WS_QM = WS_VTF + (size_t)NTOK * 1024 * 2;
constexpr size_t WS_KN = WS_QM + (size_t)NTOK * 1536 * 2;
constexpr size_t WS_VTM = WS_KN + (size_t)NTOK * 1024 * 2;
constexpr size_t WS_O = WS_VTM + (size_t)NTOK * 1024 * 2;
constexpr size_t WS_X1 = WS_O + (size_t)NTOK * DM * 2;
constexpr size_t WS_SLAB = WS_X1 + (size_t)NTOK * DM * 2;
constexpr size_t WS_END = WS_SLAB + (size_t)2 * 128 * 262144;

#ifndef PHASE_MASK
#define PHASE_MASK 0xffffffffu
#endif
#define PH(n) ((PHASE_MASK >> (n)) & 1u)
#ifndef REP_MASK
#define REP_MASK 0u
#endif
#define REPS(n) (1 + (int)((REP_MASK >> (n)) & 1u))
#define SSP(k) (WSP(float, WS_SS) + (size_t)(rep ? 5 : (k)) * NTOK)
#ifndef PROBE_ULIMIT
#define PROBE_ULIMIT 0x7fffffff
#endif
#ifndef SPLIT_TAIL
#define SPLIT_TAIL 1
#endif
#ifndef FUSE_RES
#define FUSE_RES 1
#endif

struct Params {
    const float *x, *c, *w_ada, *b_ada, *g1pre, *g1post, *w1g, *w1u, *w1d, *gmpre, *gmpost, *w_in, *b_forget, *g_qa, *w_uq, *g_kva, *w_ukv, *w_o,
        *g2pre, *g2post, *w2g, *w2u, *w2d;
    float* out;
    unsigned char* ws;
};

typedef const Params __attribute__((address_space(4)))* KP;
DEVI KP kparams() { KP kp = (KP)__builtin_amdgcn_kernarg_segment_ptr(); asm volatile("" : "+s"(kp)); return kp; }
DEVI unsigned cvt_pk_bf16(float lo, float hi) { unsigned r; asm("v_cvt_pk_bf16_f32 %0, %1, %2" : "=v"(r) : "v"(lo), "v"(hi)); return r; }
DEVI int phase_tid() { int t = threadIdx.x; asm volatile("" : "+v"(t)); return t; }
DEVI float bf2f(unsigned short v) { return __uint_as_float((unsigned)v << 16); }
DEVI float fast_exp2(float x) { return __builtin_amdgcn_exp2f(x); }
DEVI float silu_f(float g) { return g * __builtin_amdgcn_rcpf(1.0f + __expf(-g)); }
DEVI int perm32(int rho) { const int n = rho >> 4, i = rho & 15; return 8 * (i >> 2) + 4 * n + (i & 3); }
DEVI int permcol(int r) { return (r & ~31) + perm32(r & 31); }

struct MapPlain { const float* W; DEVI const float* base() const { return W; } DEVI const float* operator()(int r) const { return W + permcol(r); } };
struct MapUp { const float *Wg, *Wu; DEVI const float* base() const { return Wg; } DEVI const float* operator()(int r) const { const int t = r >> 8, w = r & 255, half = w >> 7; const uintptr_t mk = (uintptr_t)0 - (uintptr_t)half; const float* base = (const float*)(((uintptr_t)Wg & ~mk) | ((uintptr_t)Wu & mk)); return base + t * 128 + permcol(w & 127); } };
struct MapIn { const float* W;
    DEVI const float* base() const { return W; }
    DEVI const float* operator()(int r) const {
        const int l = permcol(r);
        int c;
        if (l < 768) c = l;
        else if (l < 1024) { const int j = l - 768, bj = j >> 7, jj = j & 127;
            if (jj < 32) c = 768 + bj * 32 + jj;
            else if (bj == 0 && jj < 40) c = 3904 + jj - 32;
            else c = -1; }
        else if (l < 2048) c = 832 + l - 1024;
        else if (l < 3072) c = 1856 + l - 2048;
        else c = 2880 + l - 3072;
        return c < 0 ? nullptr : W + c;
    } };
struct MapUq { const float* W;
    DEVI const float* base() const { return W; }
    DEVI const float* operator()(int r) const {
        const int l = permcol(r);
        if (l < 1024) return W + (l >> 7) * 192 + (l & 127);
        const int t = (l - 1024) >> 8, j = (l - 1024) & 255, bj = j >> 7, jj = j & 127, hh = jj >> 5, i = jj & 31;
        return W + (4 * t + hh) * 192 + 128 + bj * 32 + i;
    } };
struct MapUkv { const float* W;
    DEVI const float* base() const { return W; }
    DEVI const float* operator()(int r) const {
        const int l = permcol(r);
        if (l < 1024) return W + (l >> 7) * 256 + (l & 127);
        return W + ((l - 1024) >> 7) * 256 + 128 + (l & 127);
    } };

#define RBAR() do { asm volatile("s_waitcnt lgkmcnt(0)" ::: "memory"); __builtin_amdgcn_s_barrier(); asm volatile("" ::: "memory"); } while (0)
template <class Map>
DEVI void conv_weight(const Map& map, bf16_t* __restrict__ Bt, int Nrows, int K, int ldw, const float* __restrict__ rs, int first = 0, int rot = 0) {
    extern __shared__ __attribute__((aligned(16))) unsigned char shm[];
    float* tile = (float*)shm;
    if ((int)blockIdx.x < first) return;
    const int tid = phase_tid(), nkb = K >> 7, nun = (Nrows >> 6) * nkb, G = (int)gridDim.x - first;
    const int n = tid & 63, kq = tid >> 6, rn = tid >> 3, kc = tid & 7;
    float v[16], w[16];
#define CONV_LOAD(dst, uu) do { const int rb_ = (uu) / nkb, kb_ = (uu) - rb_ * nkb; const float* scp_ = map(rb_ * 64 + n); \
        const float msk_ = scp_ ? 1.0f : 0.0f; const float* p_ = (scp_ ? scp_ : map.base()) + (size_t)(kb_ * 128 + kq) * ldw;     \
        _Pragma("unroll") for (int it = 0; it < 16; ++it) dst[it] = __builtin_nontemporal_load(p_ + (size_t)(8 * it) * ldw) * msk_; } while (0)
    int u = ((int)blockIdx.x - first + rot) % G;
    if (u < nun) CONV_LOAD(v, u);
    for (; u < nun; u += G) {
        if (u + G < nun) CONV_LOAD(w, u + G);
        const int rb = u / nkb, kb = u - rb * nkb, r0 = rb * 64, k0 = kb * 128;
        if (rs) {
#pragma unroll
            for (int it = 0; it < 16; ++it) v[it] *= rs[k0 + kq + 8 * it];
        }
        RBAR();
#pragma unroll
        for (int it = 0; it < 16; ++it) tile[(kq + 8 * it) * 65 + n] = v[it];
        RBAR();
        unsigned pk[8];
#pragma unroll
        for (int j = 0; j < 8; ++j) pk[j] = cvt_pk_bf16(tile[(kc * 16 + 2 * j) * 65 + rn], tile[(kc * 16 + 2 * j + 1) * 65 + rn]);
        u32x4* dst = (u32x4*)(Bt + (size_t)(r0 + rn) * K + k0 + kc * 16);
        dst[0] = (u32x4){pk[0], pk[1], pk[2], pk[3]};
        dst[1] = (u32x4){pk[4], pk[5], pk[6], pk[7]};
#pragma unroll
        for (int it = 0; it < 16; ++it) v[it] = w[it];
    }
    RBAR();
#undef CONV_LOAD
}

DEVI void ada_gemv(const float* __restrict__ w_ada, const float* __restrict__ b_ada, const float* __restrict__ cvec, unsigned char* ws) {
    float* mod = (float*)(ws + WS_MOD);
    const int tid = phase_tid();
    for (int u = blockIdx.x; u < 9 * 32; u += gridDim.x) {
        const int cb = u % 9, kc = u / 9, col = cb * 2048 + tid * 4, k0 = kc * 64;
        f32x4 a0 = {0.f, 0.f, 0.f, 0.f}, a1 = {0.f, 0.f, 0.f, 0.f};
#pragma unroll 8
        for (int k = 0; k < 64; ++k) {
            const f32x4 w = __builtin_nontemporal_load((const f32x4*)(w_ada + (size_t)(k0 + k) * NMOD + col));
            const float c0 = silu_f(cvec[k0 + k]), c1 = silu_f(cvec[DM + k0 + k]);
            a0 += c0 * w; a1 += c1 * w;
        }
        if (kc == 0) { const f32x4 bb = *(const f32x4*)(b_ada + col); a0 += bb; a1 += bb; }
#pragma unroll
        for (int j = 0; j < 4; ++j) { unsafeAtomicAdd(mod + col + j, a0[j]); unsafeAtomicAdd(mod + NMOD + col + j, a1[j]); }
    }
}

DEVI void rope_table(unsigned char* ws) {
    float* rc = (float*)(ws + WS_ROPEC); float* rsn = (float*)(ws + WS_ROPES);
    for (int idx = blockIdx.x * 512 + phase_tid(); idx < SEQ * 32; idx += gridDim.x * 512) {
        const int pos = idx >> 5, i = idx & 31;
        const float inv = exp2f(-(float)i * (13.287712379549449f / 32.0f));
        const float ang = (float)pos * inv;
        double rev = (double)ang * 0.15915494309189535; rev -= rint(rev);
        rc[idx] = __builtin_amdgcn_cosf((float)rev);
        rsn[idx] = __builtin_amdgcn_sinf((float)rev);
    }
}

DEVI void rowpass_h1(const float* __restrict__ xin, const float* __restrict__ gpre, const float* __restrict__ shift, const float* __restrict__ scale, bf16_t* __restrict__ H) {
    const int tid_ = phase_tid(); const int wid = tid_ >> 6, lane = tid_ & 63;
    const int stride = (int)gridDim.x * 8;
    int row = blockIdx.x * 8 + wid;
    f32x4 xc[8], xn[8];
    const int l4c = lane * 4;
    if (row < NTOK) {
#pragma unroll
        for (int ch = 0; ch < 8; ++ch) xc[ch] = __builtin_nontemporal_load((const f32x4*)(xin + (size_t)row * DM + ch * 256 + l4c));
    }
    for (; row < NTOK; row += stride) {
        const int b = row >> 12, rown = row + stride;
        int l4 = lane * 4; asm volatile("" : "+v"(l4));
        if (rown < NTOK) {
#pragma unroll
            for (int ch = 0; ch < 8; ++ch) xn[ch] = __builtin_nontemporal_load((const f32x4*)(xin + (size_t)rown * DM + ch * 256 + l4));
        }
        float ss = 0.f;
#pragma unroll
        for (int ch = 0; ch < 8; ++ch) ss += xc[ch][0] * xc[ch][0] + xc[ch][1] * xc[ch][1] + xc[ch][2] * xc[ch][2] + xc[ch][3] * xc[ch][3];
#pragma unroll
        for (int o = 32; o >= 1; o >>= 1) ss += __shfl_xor(ss, o);
        const float rstd = rsqrtf(ss * (1.0f / DM) + EPS);
#pragma unroll
        for (int ch = 0; ch < 8; ++ch) {
            const int col = ch * 256 + l4;
            const f32x4 gp = *(const f32x4*)(gpre + col);
            const f32x4 sc = *(const f32x4*)(scale + (size_t)b * NMOD + col);
            const f32x4 sh = *(const f32x4*)(shift + (size_t)b * NMOD + col);
            const f32x4 hv = (xc[ch] * rstd * gp) * (1.0f + sc) + sh;
            u32x2 o2; o2.x = cvt_pk_bf16(hv[0], hv[1]); o2.y = cvt_pk_bf16(hv[2], hv[3]);
            *(u32x2*)(H + (size_t)row * DM + col) = o2;
        }
#pragma unroll
        for (int ch = 0; ch < 8; ++ch) xc[ch] = xn[ch];
    }
}

template <bool HAS_Y, bool HAS_H, bool XIN_BF, bool XOUT_BF>
DEVI void rowpass(const void* xin_, void* xout_, const bf16_t* __restrict__ Y, const float* __restrict__ ssy, const float* __restrict__ gpost, const float* __restrict__ gate,
                  float coeff, const float* __restrict__ gpre, const float* __restrict__ shift, const float* __restrict__ scale, bf16_t* __restrict__ H) {
    const int tid_ = phase_tid(); const int wid = tid_ >> 6, lane = tid_ & 63;
    for (int row = blockIdx.x * 8 + wid; row < NTOK; row += gridDim.x * 8) {
        const int b = row >> 12;
        int l4 = lane * 4; asm volatile("" : "+v"(l4));
        f32x4 xv[8];
        float rstd_y = 0.f;
        if (HAS_Y) rstd_y = rsqrtf(ssy[row] * (1.0f / DM) + EPS);
        float ss = 0.f;
#pragma unroll
        for (int ch = 0; ch < 8; ++ch) {
            const int col = ch * 256 + l4;
            f32x4 xx;
            if (XIN_BF) { const u32x2 xb = *(const u32x2*)((const bf16_t*)xin_ + (size_t)row * DM + col);
                xx = (f32x4){__uint_as_float(xb.x << 16), __uint_as_float(xb.x & 0xffff0000u), __uint_as_float(xb.y << 16), __uint_as_float(xb.y & 0xffff0000u)}; }
            else xx = *(const f32x4*)((const float*)xin_ + (size_t)row * DM + col);
            if (HAS_Y) {
                const u32x2 yy = *(const u32x2*)(Y + (size_t)row * DM + col);
                const f32x4 gp = *(const f32x4*)(gpost + col);
                const f32x4 gt = *(const f32x4*)(gate + (size_t)b * NMOD + col);
                f32x4 yv = {__uint_as_float(yy.x << 16), __uint_as_float(yy.x & 0xffff0000u), __uint_as_float(yy.y << 16), __uint_as_float(yy.y & 0xffff0000u)};
                xx += coeff * gt * (yv * rstd_y * gp);
                if (XOUT_BF) { u32x2 xo; xo.x = cvt_pk_bf16(xx[0], xx[1]); xo.y = cvt_pk_bf16(xx[2], xx[3]); *(u32x2*)((bf16_t*)xout_ + (size_t)row * DM + col) = xo;
                    xx = (f32x4){__uint_as_float(xo.x << 16), __uint_as_float(xo.x & 0xffff0000u), __uint_as_float(xo.y << 16), __uint_as_float(xo.y & 0xffff0000u)}; }
                else *(f32x4*)((float*)xout_ + (size_t)row * DM + col) = xx;
            }
            xv[ch] = xx;
            ss += xx[0] * xx[0] + xx[1] * xx[1] + xx[2] * xx[2] + xx[3] * xx[3];
        }
        if (HAS_H) {
#pragma unroll
            for (int o = 32; o >= 1; o >>= 1) ss += __shfl_xor(ss, o);
            const float rstd = rsqrtf(ss * (1.0f / DM) + EPS);
#pragma unroll
            for (int ch = 0; ch < 8; ++ch) {
                const int col = ch * 256 + l4;
                const f32x4 gp = *(const f32x4*)(gpre + col);
                const f32x4 sc = *(const f32x4*)(scale + (size_t)b * NMOD + col);
                const f32x4 sh = *(const f32x4*)(shift + (size_t)b * NMOD + col);
                const f32x4 hv = (xv[ch] * rstd * gp) * (1.0f + sc) + sh;
                u32x2 o2; o2.x = cvt_pk_bf16(hv[0], hv[1]); o2.y = cvt_pk_bf16(hv[2], hv[3]);
                *(u32x2*)(H + (size_t)row * DM + col) = o2;
            }
        }
    }
}

DEVI int lds_byte(int r, int c) { const int st = (r >> 4) * 2 + (c >> 5), rr = r & 15, cc = c & 31, ob = rr * 64 + cc * 2; return st * 1024 + (ob ^ (((ob >> 9) & 1) << 5)); }
DEVI void stage_rc(int b, int& R, int& C) { const int st = b / 1024, sb = b % 1024, swz = sb ^ (((sb >> 9) & 1) << 5); R = (st >> 1) * 16 + swz / 64; C = (st & 1) * 32 + (swz % 64) / 2; }

DEVI bool next_unit(int i, int nM, int nN, int& pm, int& pn, int ulimit = 0x7fffffff) {
    const int nwg = nM * nN; const long L = (long)i * gridDim.x + blockIdx.x; if (L >= nwg || L >= ulimit) return false;
    int wgid = (int)L; { const int q = nwg / 8, r = nwg % 8, xcd = wgid % 8, off = wgid / 8; wgid = (xcd < r ? xcd * (q + 1) : r * (q + 1) + (xcd - r) * q) + off; }
    const int nig = 8 * nN, gid = wgid / nig, fm = gid * 8, gsz = (nM - fm) < 8 ? (nM - fm) : 8;
    pm = fm + ((wgid % nig) % gsz); pn = (wgid % nig) / gsz; return true;
}

DEVI void tile_of(int wgid, int nM, int nN, int& pm, int& pn) {
    const int nwg = nM * nN;
    { const int q = nwg / 8, r = nwg % 8, xcd = wgid % 8, off = wgid / 8; wgid = (xcd < r ? xcd * (q + 1) : r * (q + 1) + (xcd - r) * q) + off; }
    const int nig = 8 * nN, gid = wgid / nig, fm = gid * 8, gsz = (nM - fm) < 8 ? (nM - fm) : 8;
    pm = fm + ((wgid % nig) % gsz); pn = (wgid % nig) / gsz;
}
DEVI bool next_unit_split(int i, int nM, int nN, int nt, int& pm, int& pn, int& k0, int& nk, int& role) {
    const int nwg = nM * nN, G = (int)gridDim.x, full = (nwg / G) * G;
    const long L = (long)i * G + blockIdx.x;
    if (L < full) { tile_of((int)L, nM, nN, pm, pn); k0 = 0; nk = nt; role = 0; return true; }
    if (L >= full + G || nwg - full != G / 2) return false;
    const int r = (int)(L - full), half = G / 2;
    tile_of(full + (r % half), nM, nN, pm, pn);
    role = r < half ? 1 : 2; nk = nt / 2; k0 = role == 2 ? nt / 2 : 0;
    return true;
}
#define XB_TMO      128
#define XB_SPIN_CAP (1u << 18)
DEVI unsigned xb_ld(unsigned* p) { return __hip_atomic_load(p, __ATOMIC_RELAXED, __HIP_MEMORY_SCOPE_AGENT); }
DEVI unsigned xb_add(unsigned* p, unsigned v) { return __hip_atomic_fetch_add(p, v, __ATOMIC_RELAXED, __HIP_MEMORY_SCOPE_AGENT); }
#define XB_SPIN(cond, bar) do { unsigned _sp = 0; while (cond) { __builtin_amdgcn_s_sleep(1); \
    if ((++_sp & 255u) == 0u) { if (xb_ld(&(bar)[XB_TMO])) break; if (_sp > XB_SPIN_CAP) { atomicAdd(&(bar)[XB_TMO], 1u); break; } } } } while (0)

typedef f32x4 acc_t[2][2][4][2];
#define LAS __attribute__((address_space(3)))

#ifndef GEMM_SP2
#define GEMM_SP2 true
#endif
#ifndef GEMM_ALIGN
#define GEMM_ALIGN true
#endif
template <bool SPLIT = false, class Epi>
DEVI void gemm_phase(const bf16_t* __restrict__ A, const bf16_t* __restrict__ Bt, const int M, const int N, const int K, const Epi& E, const int ulimit = 0x7fffffff,
                     float* slab = nullptr, unsigned* flags = nullptr, unsigned* ctl = nullptr) {
    extern __shared__ __attribute__((aligned(16))) unsigned char shm[];
    LAS unsigned char* lds = (LAS unsigned char*)shm;
    constexpr int BK = 64, HALF = 128, HTB = HALF * BK * 2;
    const int tid = phase_tid(), wid = __builtin_amdgcn_readfirstlane(tid >> 6), lane = tid & 63, wr = wid >> 2, wc = wid & 3, fr = lane & 15, fq = lane >> 4;
    const int nt = K / BK, nM = M / 256, nN = N / 256;
    unsigned voff[2];
#pragma unroll
    for (int i = 0; i < 2; ++i) { int R, C; stage_rc(tid * 16 + i * 8192, R, C); voff[i] = (unsigned)(R * K + C) * 2u; }
    const size_t kstep = (size_t)(BK * 2);
    const size_t hstep = (size_t)HALF * K * 2;
    const size_t tstep = 2 * hstep;
    const unsigned ldsw = (unsigned)wid * 1024u;
    const int aoff = lds_byte(wr * 64 + fr, fq * 8), boff = lds_byte(wc * 32 + fr, fq * 8);
#define PG8_SA(b, h) (((b) * 2 + (h)) * HTB)
#define PG8_SB(b, h) ((4 + (b) * 2 + (h)) * HTB)
#define PG8_STAGE(bufoff, gbase) do { _Pragma("unroll") for (int _i = 0; _i < 2; ++_i) \
        __builtin_amdgcn_global_load_lds((const unsigned*)((const char*)(gbase) + voff[_i]), (LAS unsigned*)(lds + (bufoff) + ldsw + _i * 8192), 16, 0, 0); } while (0)
#define PG8_LDA(dst, b, h) do { _Pragma("unroll") for (int m = 0; m < 4; ++m) _Pragma("unroll") for (int k = 0; k < 2; ++k) dst[m][k] = *(const LAS bf16x8*)(lds + PG8_SA(b, h) + aoff + m * 2048 + k * 1024); } while (0)
#define PG8_LDB(dst, b, h) do { _Pragma("unroll") for (int n = 0; n < 2; ++n) _Pragma("unroll") for (int k = 0; k < 2; ++k) dst[n][k] = *(const LAS bf16x8*)(lds + PG8_SB(b, h) + boff + n * 2048 + k * 1024); } while (0)
#define PG8_MMA(ai, bj, At_, Bt_) do { __builtin_amdgcn_s_setprio(1); _Pragma("unroll") for (int m = 0; m < 4; ++m) _Pragma("unroll") for (int n = 0; n < 2; ++n) _Pragma("unroll") for (int k = 0; k < 2; ++k) \
        acc[ai][bj][m][n] = __builtin_amdgcn_mfma_f32_16x16x32_bf16(Bt_[n][k], At_[m][k], acc[ai][bj][m][n], 0, 0, 0); __builtin_amdgcn_s_setprio(0); } while (0)
#define PG8_WAIT_V(n) asm volatile("s_waitcnt vmcnt(" #n ")" ::: "memory")
#define PG8_WAIT_L(n) asm volatile("s_waitcnt lgkmcnt(" #n ")" ::: "memory")
#define PG8_BAR __builtin_amdgcn_s_barrier()
#define PG8_SCHED __builtin_amdgcn_sched_barrier(0)
    int cpm, cpn, npm = 0, npn = 0, ui = 0;
    int ck0 = 0, cnk = nt, crole = 0, nk0 = 0, nnk = nt, nrole = 0;
    if constexpr (SPLIT) { if (!next_unit_split(0, nM, nN, nt, cpm, cpn, ck0, cnk, crole)) return; }
    else { if (!next_unit(0, nM, nN, cpm, cpn, ulimit)) return; }
    acc_t acc;
#pragma unroll
    for (int a = 0; a < 2; ++a)
#pragma unroll
        for (int b = 0; b < 2; ++b)
#pragma unroll
            for (int m = 0; m < 4; ++m)
#pragma unroll
                for (int n = 0; n < 2; ++n) acc[a][b][m][n] = (f32x4){0.f, 0.f, 0.f, 0.f};
    bf16x8 At[4][2], B0[2][2], B1[2][2];
    const char* cA = (const char*)A + (size_t)cpm * tstep + (size_t)ck0 * kstep; const char* cB = (const char*)Bt + (size_t)cpn * tstep + (size_t)ck0 * kstep;
    constexpr bool SP2 = GEMM_SP2, ALIGN_EPI = GEMM_ALIGN && !Epi::AFTER_DRAIN;
    if constexpr (SP2) {
        PG8_STAGE(PG8_SB(0, 0), cB); PG8_STAGE(PG8_SB(0, 1), cB + hstep); PG8_STAGE(PG8_SA(0, 0), cA); PG8_STAGE(PG8_SA(0, 1), cA + hstep);
        if (wr == 1) PG8_BAR;
        PG8_WAIT_V(2); PG8_BAR;
        PG8_STAGE(PG8_SB(1, 0), cB + kstep); PG8_STAGE(PG8_SA(1, 0), cA + kstep); PG8_STAGE(PG8_SB(1, 1), cB + hstep + kstep);
        PG8_WAIT_V(6); PG8_BAR;
    } else {
        PG8_STAGE(PG8_SB(0, 0), cB); PG8_STAGE(PG8_SA(0, 0), cA); PG8_STAGE(PG8_SB(0, 1), cB + hstep); PG8_STAGE(PG8_SA(0, 1), cA + hstep);
        if (wr == 1) PG8_BAR;
        PG8_WAIT_V(4); PG8_BAR;
        PG8_STAGE(PG8_SB(1, 0), cB + kstep); PG8_STAGE(PG8_SA(1, 0), cA + kstep); PG8_STAGE(PG8_SB(1, 1), cB + hstep + kstep);
        PG8_WAIT_V(6); PG8_BAR;
    }
    for (;;) {
        bool has_next;
        if constexpr (SPLIT) has_next = next_unit_split(ui + 1, nM, nN, nt, npm, npn, nk0, nnk, nrole);
        else has_next = next_unit(ui + 1, nM, nN, npm, npn, ulimit);
        const char* nA = has_next ? (const char*)A + (size_t)npm * tstep + (size_t)nk0 * kstep : cA; const char* nB = has_next ? (const char*)Bt + (size_t)npn * tstep + (size_t)nk0 * kstep : cB;
        for (int t = 0; t < cnk; t += 2) {
            const bool last = (t == cnk - 2);
            const char* a1 = cA + (size_t)(t + 1) * kstep;
            const char* a2 = last ? nA : cA + (size_t)(t + 2) * kstep; const char* b2 = last ? nB : cB + (size_t)(t + 2) * kstep;
            const char* a3 = a2 + kstep; const char* b3 = b2 + kstep;
            if constexpr (SP2) {
            PG8_LDB(B0, 0, 0); PG8_LDB(B1, 0, 1); PG8_SCHED; PG8_LDA(At, 0, 0); PG8_STAGE(PG8_SA(1, 1), a1 + hstep);
            PG8_WAIT_V(8); PG8_WAIT_L(0); PG8_BAR; PG8_MMA(0, 0, At, B0); PG8_MMA(0, 1, At, B1); PG8_BAR; PG8_SCHED;
            PG8_LDA(At, 0, 1); PG8_STAGE(PG8_SB(0, 0), b2); PG8_STAGE(PG8_SB(0, 1), b2 + hstep); PG8_STAGE(PG8_SA(0, 0), a2);
            PG8_WAIT_V(8); PG8_WAIT_L(0); PG8_BAR; PG8_MMA(1, 0, At, B0); PG8_MMA(1, 1, At, B1); PG8_BAR; PG8_SCHED;
            PG8_LDB(B0, 1, 0); PG8_LDB(B1, 1, 1); PG8_SCHED; PG8_LDA(At, 1, 0); PG8_STAGE(PG8_SA(0, 1), a2 + hstep);
            PG8_WAIT_V(8); PG8_WAIT_L(0); PG8_BAR; PG8_MMA(0, 0, At, B0); PG8_MMA(0, 1, At, B1); PG8_BAR; PG8_SCHED;
            PG8_LDA(At, 1, 1); PG8_STAGE(PG8_SB(1, 0), b3); PG8_STAGE(PG8_SB(1, 1), b3 + hstep); PG8_STAGE(PG8_SA(1, 0), a3);
            PG8_WAIT_V(8); PG8_WAIT_L(0); PG8_BAR; PG8_MMA(1, 0, At, B0); PG8_MMA(1, 1, At, B1); PG8_BAR; PG8_SCHED;
            } else {
            PG8_LDB(B0, 0, 0); PG8_SCHED; PG8_LDA(At, 0, 0); PG8_STAGE(PG8_SA(1, 1), a1 + hstep);
            PG8_WAIT_L(8); PG8_BAR; PG8_WAIT_L(0); PG8_MMA(0, 0, At, B0); PG8_BAR; PG8_SCHED;
            PG8_LDB(B1, 0, 1); PG8_STAGE(PG8_SB(0, 0), b2);
            PG8_BAR; PG8_WAIT_L(0); PG8_MMA(0, 1, At, B1); PG8_BAR;
            PG8_LDA(At, 0, 1); PG8_STAGE(PG8_SA(0, 0), a2);
            PG8_BAR; PG8_WAIT_L(0); PG8_MMA(1, 0, At, B0); PG8_BAR; PG8_SCHED;
            PG8_STAGE(PG8_SB(0, 1), b2 + hstep);
            PG8_WAIT_V(6); PG8_BAR; PG8_MMA(1, 1, At, B1); PG8_BAR;
            PG8_LDB(B0, 1, 0); PG8_SCHED; PG8_LDA(At, 1, 0); PG8_STAGE(PG8_SA(0, 1), a2 + hstep);
            PG8_WAIT_L(8); PG8_BAR; PG8_WAIT_L(0); PG8_MMA(0, 0, At, B0); PG8_BAR; PG8_SCHED;
            PG8_LDB(B1, 1, 1); PG8_STAGE(PG8_SB(1, 0), b3);
            PG8_BAR; PG8_WAIT_L(0); PG8_MMA(0, 1, At, B1); PG8_BAR;
            PG8_LDA(At, 1, 1); PG8_STAGE(PG8_SA(1, 0), a3);
            PG8_BAR; PG8_WAIT_L(0); PG8_MMA(1, 0, At, B0); PG8_BAR; PG8_SCHED;
            PG8_STAGE(PG8_SB(1, 1), b3 + hstep);
            PG8_WAIT_V(6); PG8_BAR; PG8_MMA(1, 1, At, B1); PG8_BAR;
            }
        }
        if constexpr (ALIGN_EPI) { if (wr == 0) PG8_BAR; }
        if constexpr (!Epi::AFTER_DRAIN) { if (!SPLIT || crole == 0) E(acc, cpm, cpn, wr, wc, fr, fq); }
        if (!has_next) break;
#pragma unroll
        for (int a = 0; a < 2; ++a)
#pragma unroll
            for (int b = 0; b < 2; ++b)
#pragma unroll
                for (int m = 0; m < 4; ++m)
#pragma unroll
                    for (int n = 0; n < 2; ++n) acc[a][b][m][n] = (f32x4){0.f, 0.f, 0.f, 0.f};
        cpm = npm; cpn = npn; cA = nA; cB = nB; ++ui;
        if constexpr (SPLIT) { ck0 = nk0; cnk = nnk; crole = nrole; }
        if constexpr (ALIGN_EPI) { if (wr == 1) PG8_BAR; }
    }
    PG8_WAIT_V(0);
    if constexpr (!ALIGN_EPI) { if (wr == 0) PG8_BAR; }
    PG8_BAR;
    if constexpr (Epi::AFTER_DRAIN) E.fused(acc, cpm, cpn, wr, wc, fr, fq);
    if constexpr (SPLIT) {
        if (crole != 0) {
            const int pair = (int)blockIdx.x & ((int)gridDim.x / 2 - 1);
            float* sl = slab + (size_t)pair * 65536 + (size_t)tid * 4;
            if (crole == 2) {
#pragma unroll
                for (int a = 0; a < 2; ++a)
#pragma unroll
                    for (int b = 0; b < 2; ++b)
#pragma unroll
                        for (int m = 0; m < 4; ++m)
#pragma unroll
                            for (int n = 0; n < 2; ++n) {
                                float* ptr = sl + (size_t)(((a * 2 + b) * 4 + m) * 2 + n) * 2048;
                                asm volatile("global_store_dwordx4 %0, %1, off sc0 sc1\n\ts_nop 2" :: "v"(ptr), "v"(acc[a][b][m][n]) : "memory");
                            }
                asm volatile("s_waitcnt vmcnt(0)" ::: "memory");
                __syncthreads();
                if (threadIdx.x == 0) __hip_atomic_store(flags + pair * 16, 1u, __ATOMIC_RELAXED, __HIP_MEMORY_SCOPE_AGENT);
            } else {
                if (threadIdx.x == 0) { XB_SPIN(xb_ld(flags + pair * 16) == 0u, ctl); __builtin_amdgcn_fence(__ATOMIC_ACQUIRE, "agent"); asm volatile("s_waitcnt vmcnt(0)" ::: "memory"); }
                __syncthreads();
                E.with_partial(acc, sl, cpm, cpn, wr, wc, fr, fq);
            }
        }
    }
#undef PG8_SA
#undef PG8_SB
#undef PG8_STAGE
#undef PG8_LDA
#undef PG8_LDB
#undef PG8_MMA
}

struct EpiNull {
    static constexpr bool AFTER_DRAIN = false;
    float* sink;
    DEVI void operator()(const acc_t& acc, int pm, int pn, int wr, int wc, int fr, int fq) const {
        if (pm < 0) {
#pragma unroll
            for (int ai = 0; ai < 2; ++ai)
#pragma unroll
                for (int bj = 0; bj < 2; ++bj)
#pragma unroll
                    for (int m = 0; m < 4; ++m) { *(f32x4*)(sink + fr * 8) = acc[ai][bj][m][0]; *(f32x4*)(sink + fq * 8 + 4) = acc[ai][bj][m][1]; }
        }
    }
};
struct EpiSwiglu {
    static constexpr bool AFTER_DRAIN = false;
    bf16_t* U;
    template <bool PART>
    DEVI void run(const acc_t& acc, const float* sl, int pm, int pn, int wr, int wc, int fr, int fq) const {
        f32x4 pc[4] = {}, pnx[4] = {};
#define PLOAD(dst, it_) do { const int ai_ = (it_) >> 2, m_ = (it_) & 3; \
        dst[0] = *(const f32x4*)(sl + (size_t)(((ai_ * 2 + 0) * 4 + m_) * 2 + 0) * 2048); dst[1] = *(const f32x4*)(sl + (size_t)(((ai_ * 2 + 0) * 4 + m_) * 2 + 1) * 2048); \
        dst[2] = *(const f32x4*)(sl + (size_t)(((ai_ * 2 + 1) * 4 + m_) * 2 + 0) * 2048); dst[3] = *(const f32x4*)(sl + (size_t)(((ai_ * 2 + 1) * 4 + m_) * 2 + 1) * 2048); } while (0)
        if (PART) PLOAD(pc, 0);
#pragma unroll
        for (int it = 0; it < 8; ++it) {
            const int ai = it >> 2, m = it & 3;
            const int row = pm * 256 + ai * 128 + wr * 64 + m * 16 + fr;
            if (PART && it < 7) PLOAD(pnx, it + 1);
            f32x4 g0 = acc[ai][0][m][0], g1 = acc[ai][0][m][1], u0 = acc[ai][1][m][0], u1 = acc[ai][1][m][1];
            if (PART) { g0 += pc[0]; g1 += pc[1]; u0 += pc[2]; u1 += pc[3]; }
            u32x4 w;
            w.x = cvt_pk_bf16(silu_f(g0[0]) * u0[0], silu_f(g0[1]) * u0[1]);
            w.y = cvt_pk_bf16(silu_f(g0[2]) * u0[2], silu_f(g0[3]) * u0[3]);
            w.z = cvt_pk_bf16(silu_f(g1[0]) * u1[0], silu_f(g1[1]) * u1[1]);
            w.w = cvt_pk_bf16(silu_f(g1[2]) * u1[2], silu_f(g1[3]) * u1[3]);
            *(u32x4*)(U + (size_t)row * DFF + pn * 128 + wc * 32 + 8 * fq) = w;
            if (PART) { pc[0] = pnx[0]; pc[1] = pnx[1]; pc[2] = pnx[2]; pc[3] = pnx[3]; }
        }
#undef PLOAD
    }
    DEVI void operator()(const acc_t& acc, int pm, int pn, int wr, int wc, int fr, int fq) const { run<false>(acc, nullptr, pm, pn, wr, wc, fr, fq); }
    DEVI void with_partial(const acc_t& acc, const float* sl, int pm, int pn, int wr, int wc, int fr, int fq) const { run<true>(acc, sl, pm, pn, wr, wc, fr, fq); }
};
DEVI u32x4 pack8(const f32x4 a, const f32x4 b, float s) {
    u32x4 w; w.x = cvt_pk_bf16(a[0] * s, a[1] * s); w.y = cvt_pk_bf16(a[2] * s, a[3] * s); w.z = cvt_pk_bf16(b[0] * s, b[1] * s); w.w = cvt_pk_bf16(b[2] * s, b[3] * s); return w;
}
DEVI float sq8(const f32x4 a, const f32x4 b) { return a[0] * a[0] + a[1] * a[1] + a[2] * a[2] + a[3] * a[3] + b[0] * b[0] + b[1] * b[1] + b[2] * b[2] + b[3] * b[3]; }
struct EpiY {
    static constexpr bool AFTER_DRAIN = false;
    bf16_t* Y; int ldy; float* ss;
    DEVI void operator()(const acc_t& acc, int pm, int pn, int wr, int wc, int fr, int fq) const {
#pragma unroll
        for (int ai = 0; ai < 2; ++ai)
#pragma unroll
            for (int m = 0; m < 4; ++m) {
                const int row = pm * 256 + ai * 128 + wr * 64 + m * 16 + fr;
                float s = 0.f;
#pragma unroll
                for (int bj = 0; bj < 2; ++bj) {
                    s += sq8(acc[ai][bj][m][0], acc[ai][bj][m][1]);
                    *(u32x4*)(Y + (size_t)row * ldy + pn * 256 + bj * 128 + wc * 32 + 8 * fq) = pack8(acc[ai][bj][m][0], acc[ai][bj][m][1], 1.0f);
                }
                s += __shfl_xor(s, 16); s += __shfl_xor(s, 32);
                if (fq == 0) unsafeAtomicAdd(ss + row, s);
            }
    }
};
DEVI void store_vt_tile(bf16_t* __restrict__ Vt, const acc_t& acc, int ai, int bj, int head, int rowblk  , int wr, int wc, int fr, int fq, const float (&sc)[4]) {
    extern __shared__ __attribute__((aligned(16))) unsigned char shm[];
    LAS unsigned char* wl = (LAS unsigned char*)shm + LDS_VT + (wr * 4 + wc) * 2560;
    const int lane = fq * 16 + fr;
#pragma unroll
    for (int mh = 0; mh < 2; ++mh) {
        asm volatile("" ::: "memory");
#pragma unroll
        for (int mm = 0; mm < 2; ++mm) {
            const int m = 2 * mh + mm, tl = mm * 16 + fr;
            const u32x4 w = pack8(acc[ai][bj][m][0], acc[ai][bj][m][1], sc[m]);
            LAS unsigned short* p = (LAS unsigned short*)(wl + (8 * fq) * 80 + tl * 2);
            p[0 * 40] = (unsigned short)(w.x & 0xffff); p[1 * 40] = (unsigned short)(w.x >> 16);
            p[2 * 40] = (unsigned short)(w.y & 0xffff); p[3 * 40] = (unsigned short)(w.y >> 16);
            p[4 * 40] = (unsigned short)(w.z & 0xffff); p[5 * 40] = (unsigned short)(w.z >> 16);
            p[6 * 40] = (unsigned short)(w.w & 0xffff); p[7 * 40] = (unsigned short)(w.w >> 16);
        }
        asm volatile("s_waitcnt lgkmcnt(0)" ::: "memory");
        const int tok = rowblk + mh * 32, bb = tok >> 12, sp = tok & 4095;
#pragma unroll
        for (int k = 0; k < 2; ++k) {
            const int c = lane + 64 * k, dr = c >> 2, part = c & 3;
            const u32x4 v = *(const LAS u32x4*)(wl + dr * 80 + part * 16);
            *(u32x4*)(Vt + ((size_t)(bb * 8 + head) * 128 + wc * 32 + dr) * SEQ + sp + part * 8) = v;
        }
        asm volatile("s_waitcnt lgkmcnt(0)" ::: "memory");
    }
}
DEVI float log_sigmoid_f(float x) { const float e = __expf(-fabsf(x)); return fminf(x, 0.f) - __logf(1.0f + e); }
struct EpiIn {
    static constexpr bool AFTER_DRAIN = false;
    bf16_t *QA, *KVA, *KR, *FQ, *FK, *VTF; float *ssq, *sskv, *logf; const float *ropec, *ropes, *b_forget;
    DEVI void operator()(const acc_t& acc, int pm, int pn, int wr, int wc, int fr, int fq) const {
        const float qs = LOG2E * 0.08838834764831845f;
        if (pn >= 12) {
            const float one[4] = {1.0f, 1.0f, 1.0f, 1.0f};
#pragma unroll
            for (int ai = 0; ai < 2; ++ai)
#pragma unroll
                for (int bj = 0; bj < 2; ++bj) store_vt_tile(VTF, acc, ai, bj, 2 * (pn - 12) + bj, pm * 256 + ai * 128 + wr * 64, wr, wc, fr, fq, one);
            return;
        }
        if (pn == 3) {
            const int row0 = pm * 256 + wr * 64 + fr;
            if (wc == 0) {
                f32x4 tc[4], tn[4];
#define TLOAD(dst, it_) do { const int pos_ = (row0 + ((it_) >> 2) * 128 + ((it_) & 3) * 16) & 4095; \
                dst[0] = *(const f32x4*)(ropec + pos_ * 32 + 8 * fq); dst[1] = *(const f32x4*)(ropes + pos_ * 32 + 8 * fq); \
                dst[2] = *(const f32x4*)(ropec + pos_ * 32 + 8 * fq + 4); dst[3] = *(const f32x4*)(ropes + pos_ * 32 + 8 * fq + 4); } while (0)
                TLOAD(tc, 0);
#pragma unroll
                for (int it = 0; it < 8; ++it) {
                    const int ai = it >> 2, m = it & 3, row = row0 + ai * 128 + m * 16;
                    if (it < 7) TLOAD(tn, it + 1);
#pragma unroll
                    for (int n = 0; n < 2; ++n) {
                        const int i0 = 8 * fq + 4 * n;
                        const f32x4 cs = tc[2 * n], sn = tc[2 * n + 1];
                        const f32x4 x1 = acc[ai][0][m][n], x2 = acc[ai][1][m][n];
                        const f32x4 o1 = x1 * cs - x2 * sn, o2 = x1 * sn + x2 * cs;
                        u32x2 w1, w2; w1.x = cvt_pk_bf16(o1[0], o1[1]); w1.y = cvt_pk_bf16(o1[2], o1[3]); w2.x = cvt_pk_bf16(o2[0], o2[1]); w2.y = cvt_pk_bf16(o2[2], o2[3]);
                        *(u32x2*)(KR + (size_t)row * 64 + i0) = w1;
                        *(u32x2*)(KR + (size_t)row * 64 + 32 + i0) = w2;
                    }
#pragma unroll
                    for (int k = 0; k < 4; ++k) tc[k] = tn[k];
                }
#undef TLOAD
            } else if (wc == 1 && fq == 0) {
                f32x4 bf0 = *(const f32x4*)(b_forget), bf1 = *(const f32x4*)(b_forget + 4);
#pragma unroll
                for (int it = 0; it < 8; ++it) {
                    const int ai = it >> 2, m = it & 3, row = row0 + ai * 128 + m * 16;
                    f32x4 l0, l1;
#pragma unroll
                    for (int j = 0; j < 4; ++j) { l0[j] = log_sigmoid_f(acc[ai][0][m][0][j] + bf0[j]); l1[j] = log_sigmoid_f(acc[ai][0][m][1][j] + bf1[j]); }
                    *(f32x4*)(logf + (size_t)row * 8) = l0; *(f32x4*)(logf + (size_t)row * 8 + 4) = l1;
                }
            }
            return;
        }
#pragma unroll
        for (int ai = 0; ai < 2; ++ai)
#pragma unroll
            for (int m = 0; m < 4; ++m) {
                const int row = pm * 256 + ai * 128 + wr * 64 + m * 16 + fr;
                if (pn < 3) {
                    bf16_t* dst = pn < 2 ? QA + (size_t)row * 512 + pn * 256 : KVA + (size_t)row * 256;
                    float s = 0.f;
#pragma unroll
                    for (int bj = 0; bj < 2; ++bj) {
                        s += sq8(acc[ai][bj][m][0], acc[ai][bj][m][1]);
                        *(u32x4*)(dst + bj * 128 + wc * 32 + 8 * fq) = pack8(acc[ai][bj][m][0], acc[ai][bj][m][1], 1.0f);
                    }
                    s += __shfl_xor(s, 16); s += __shfl_xor(s, 32);
                    if (fq == 0) unsafeAtomicAdd((pn < 2 ? ssq : sskv) + row, s);
                } else {
                    bf16_t* dst = (pn < 8 ? FQ : FK) + (size_t)row * 1024 + ((pn - 4) & 3) * 256;
                    const float sc = pn < 8 ? qs : 1.0f;
#pragma unroll
                    for (int bj = 0; bj < 2; ++bj) *(u32x4*)(dst + bj * 128 + wc * 32 + 8 * fq) = pack8(acc[ai][bj][m][0], acc[ai][bj][m][1], sc);
                }
            }
    }
};
struct EpiQ {
    static constexpr bool AFTER_DRAIN = false;
    bf16_t* QM; const float *ssq, *ropec, *ropes;
    DEVI void operator()(const acc_t& acc, int pm, int pn, int wr, int wc, int fr, int fq) const {
        const float qs = LOG2E * 0.07216878364870323f;
        const int row0 = pm * 256 + wr * 64 + fr;
        float rs[8];
#pragma unroll
        for (int it = 0; it < 8; ++it) rs[it] = ssq[row0 + (it >> 2) * 128 + (it & 3) * 16];
#pragma unroll
        for (int it = 0; it < 8; ++it) rs[it] = rsqrtf(rs[it] * (1.0f / 512.0f) + EPS) * qs;
        if (pn < 4) {
#pragma unroll
            for (int it = 0; it < 8; ++it) {
                const int ai = it >> 2, m = it & 3, row = row0 + ai * 128 + m * 16;
#pragma unroll
                for (int bj = 0; bj < 2; ++bj)
                    *(u32x4*)(QM + (size_t)row * 1536 + (2 * pn + bj) * 192 + wc * 32 + 8 * fq) = pack8(acc[ai][bj][m][0], acc[ai][bj][m][1], rs[it]);
            }
        } else {
            const int head = 4 * (pn - 4) + wc;
            f32x4 tc[4], tn[4];
#define TLOAD(dst, it_) do { const int pos_ = (row0 + ((it_) >> 2) * 128 + ((it_) & 3) * 16) & 4095; \
            dst[0] = *(const f32x4*)(ropec + pos_ * 32 + 8 * fq); dst[1] = *(const f32x4*)(ropes + pos_ * 32 + 8 * fq); \
            dst[2] = *(const f32x4*)(ropec + pos_ * 32 + 8 * fq + 4); dst[3] = *(const f32x4*)(ropes + pos_ * 32 + 8 * fq + 4); } while (0)
            TLOAD(tc, 0);
#pragma unroll
            for (int it = 0; it < 8; ++it) {
                const int ai = it >> 2, m = it & 3, row = row0 + ai * 128 + m * 16;
                if (it < 7) TLOAD(tn, it + 1);
#pragma unroll
                for (int n = 0; n < 2; ++n) {
                    const int i0 = 8 * fq + 4 * n;
                    const f32x4 cs = tc[2 * n], sn = tc[2 * n + 1];
                    const f32x4 x1 = acc[ai][0][m][n] * rs[it], x2 = acc[ai][1][m][n] * rs[it];
                    const f32x4 o1 = x1 * cs - x2 * sn, o2 = x1 * sn + x2 * cs;
                    u32x2 w1, w2; w1.x = cvt_pk_bf16(o1[0], o1[1]); w1.y = cvt_pk_bf16(o1[2], o1[3]); w2.x = cvt_pk_bf16(o2[0], o2[1]); w2.y = cvt_pk_bf16(o2[2], o2[3]);
                    *(u32x2*)(QM + (size_t)row * 1536 + head * 192 + 128 + i0) = w1;
                    *(u32x2*)(QM + (size_t)row * 1536 + head * 192 + 160 + i0) = w2;
                }
#pragma unroll
                for (int k = 0; k < 4; ++k) tc[k] = tn[k];
            }
#undef TLOAD
        }
    }
};
struct EpiKV {
    static constexpr bool AFTER_DRAIN = false;
    bf16_t *KN, *VTM; const float* sskv;
    DEVI void operator()(const acc_t& acc, int pm, int pn, int wr, int wc, int fr, int fq) const {
#pragma unroll
        for (int ai = 0; ai < 2; ++ai) {
            float rs[4];
#pragma unroll
            for (int m = 0; m < 4; ++m) rs[m] = rsqrtf(sskv[pm * 256 + ai * 128 + wr * 64 + m * 16 + fr] * (1.0f / 256.0f) + EPS);
            if (pn < 4) {
#pragma unroll
                for (int m = 0; m < 4; ++m) {
                    const int row = pm * 256 + ai * 128 + wr * 64 + m * 16 + fr;
#pragma unroll
                    for (int bj = 0; bj < 2; ++bj)
                        *(u32x4*)(KN + (size_t)row * 1024 + pn * 256 + bj * 128 + wc * 32 + 8 * fq) = pack8(acc[ai][bj][m][0], acc[ai][bj][m][1], rs[m]);
                }
            } else {
#pragma unroll
                for (int bj = 0; bj < 2; ++bj) store_vt_tile(VTM, acc, ai, bj, 2 * (pn - 4) + bj, pm * 256 + ai * 128 + wr * 64, wr, wc, fr, fq, rs);
            }
        }
    }
};

DEVI void cumsum_unit(const float* __restrict__ logf, float* __restrict__ cum, int bh) {
    const int lane = phase_tid() & 63, b = bh >> 3, h = bh & 7;
    const float* src = logf + ((size_t)b * SEQ + lane * 64) * 8 + h;
    float s = 0.f;
    for (int i = 0; i < 64; ++i) s += src[i * 8];
    float incl = s;
#pragma unroll
    for (int o = 1; o < 64; o <<= 1) { const float t = __shfl_up(incl, o); if (lane >= o) incl += t; }
    float run = incl - s;
    float* dst = cum + (size_t)bh * SEQ + lane * 64;
    for (int i = 0; i < 64; ++i) { run += src[i * 8]; dst[i] = -run * LOG2E; }
}

template <int DQK, bool FOX>
DEVI void attn_item(const bf16_t* __restrict__ Q, int ldq, const bf16_t* __restrict__ K1, const bf16_t* __restrict__ K2, const bf16_t* __restrict__ Vt,
                    const float* __restrict__ cum, bf16_t* __restrict__ O, int qb) {
    extern __shared__ __attribute__((aligned(16))) unsigned char shm[];
    constexpr int KSTR = DQK * 2 + 16, VSTR = 144, CPR = DQK / 8, NKC = 64 * CPR / 512, KBUF = 64 * KSTR, VBUF = 128 * VSTR, NKS = DQK / 16;
    unsigned char* Kb = shm; unsigned char* Vb = shm + 2 * KBUF; float* Cb = (float*)(shm + 2 * KBUF + 2 * VBUF);
    const int tid = phase_tid(), wid = tid >> 6, lane = tid & 63, n = lane & 31, g = lane >> 5;
    const int Q0 = qb * 256, q0w = Q0 + wid * 32;
    const int ntile = Q0 / 64 + 4, mytiles = q0w / 64 + 1;
    const int pin = (n & 0x13) | ((n & 4) << 1) | ((n & 8) >> 1);

    bf16x8 qf[NKS];
#pragma unroll
    for (int ks = 0; ks < NKS; ++ks) qf[ks] = *(const bf16x8*)(Q + (size_t)(q0w + n) * ldq + ks * 16 + g * 8);
    f32x16 o[4];
#pragma unroll
    for (int mt = 0; mt < 4; ++mt)
#pragma unroll
        for (int i = 0; i < 16; ++i) o[mt][i] = 0.f;
    float mrun = -INFINITY, lrun = 0.f;

    u32x4 kreg[NKC], vreg[2]; float creg = 0.f;
    int kgo[2], klo[2], vgo[2], vlo[2];
#pragma unroll
    for (int i_ = 0; i_ < 2; ++i_) {
        const int c_ = tid + i_ * 512;
        kgo[i_] = (c_ >> 4) * 1024 + (c_ & 15) * 8; klo[i_] = (c_ >> 4) * KSTR + (c_ & 15) * 16;
        vgo[i_] = (c_ >> 3) * SEQ + (c_ & 7) * 8;    vlo[i_] = (c_ >> 3) * VSTR + (c_ & 7) * 16;
    }
    const int rgo = (tid >> 3) * 64 + (tid & 7) * 8, rlo = (tid >> 3) * KSTR + 256 + (tid & 7) * 16;
#define GLOAD(kt_) do { const int k0_ = (kt_) * 64; \
    const bf16_t* kb_ = K1 + (size_t)k0_ * 1024; const bf16_t* vb_ = Vt + k0_; \
    _Pragma("unroll") for (int i_ = 0; i_ < 2; ++i_) { kreg[i_] = *(const u32x4*)(kb_ + kgo[i_]); vreg[i_] = *(const u32x4*)(vb_ + vgo[i_]); } \
    if (!FOX) { const bf16_t* rb_ = K2 + (size_t)k0_ * 64; kreg[NKC - 1] = *(const u32x4*)(rb_ + rgo); } \
    if (FOX && tid < 64) creg = cum[k0_ + tid]; } while (0)
#define LSTORE(buf_) do { \
    _Pragma("unroll") for (int i_ = 0; i_ < 2; ++i_) { *(u32x4*)(Kb + (buf_) * KBUF + klo[i_]) = kreg[i_]; *(u32x4*)(Vb + (buf_) * VBUF + vlo[i_]) = vreg[i_]; } \
    if (!FOX) *(u32x4*)(Kb + (buf_) * KBUF + rlo) = kreg[NKC - 1]; \
    if (FOX && tid < 64) Cb[(buf_) * 64 + tid] = creg; } while (0)

#define TILE_OF(j_) (FOX ? (ntile - 1 - (j_)) : (j_))
    __syncthreads();
    GLOAD(TILE_OF(0)); LSTORE(0); GLOAD(TILE_OF(1));
    __syncthreads();
    for (int j = 0; j < ntile; ++j) {
        const int buf = j & 1, kt = TILE_OF(j);
        if (j + 1 < ntile) LSTORE(buf ^ 1);
        if (j + 2 < ntile) GLOAD(TILE_OF(j + 2));
        if (kt < mytiles) {
            f32x16 st[2];
            if (FOX) {
#pragma unroll
                for (int sub = 0; sub < 2; ++sub)
#pragma unroll
                    for (int half = 0; half < 2; ++half) {
                        const int kofs = sub * 32 + half * 16 + 8 * g;
                        const f32x4 c0 = *(const f32x4*)(Cb + buf * 64 + kofs), c1 = *(const f32x4*)(Cb + buf * 64 + kofs + 4);
#pragma unroll
                        for (int jj = 0; jj < 4; ++jj) { st[sub][half * 8 + jj] = c0[jj]; st[sub][half * 8 + 4 + jj] = c1[jj]; }
                    }
                if (kt == mytiles - 1) {
                    const int tq = q0w + n;
#pragma unroll
                    for (int sub = 0; sub < 2; ++sub)
#pragma unroll
                        for (int i = 0; i < 16; ++i) { const int key = kt * 64 + sub * 32 + (i >> 3) * 16 + 8 * g + (i & 7); if (key > tq) st[sub][i] = -INFINITY; }
                }
            } else {
#pragma unroll
                for (int sub = 0; sub < 2; ++sub)
#pragma unroll
                    for (int i = 0; i < 16; ++i) st[sub][i] = 0.f;
            }
#pragma unroll
            for (int sub = 0; sub < 2; ++sub) {
                const unsigned char* kb = Kb + buf * KBUF + (sub * 32 + pin) * KSTR + g * 16;
#pragma unroll
                for (int ks = 0; ks < NKS; ++ks) st[sub] = __builtin_amdgcn_mfma_f32_32x32x16_bf16(*(const bf16x8*)(kb + ks * 32), qf[ks], st[sub], 0, 0, 0);
            }
            float mx = st[0][0];
#pragma unroll
            for (int i = 1; i < 16; ++i) mx = fmaxf(mx, st[0][i]);
#pragma unroll
            for (int i = 0; i < 16; ++i) mx = fmaxf(mx, st[1][i]);
            mx = fmaxf(mx, __shfl_xor(mx, 32));
            if (FOX) {
                const float mnew = fmaxf(mrun, mx);
                const float alpha = fast_exp2(mrun - mnew);
                mrun = mnew; lrun *= alpha;
                if (__builtin_amdgcn_ballot_w64(alpha != 1.0f) != 0ull) {
#pragma unroll
                    for (int mt = 0; mt < 4; ++mt)
#pragma unroll
                        for (int i = 0; i < 16; ++i) o[mt][i] *= alpha;
                }
            } else {
                if (__builtin_amdgcn_ballot_w64(!(mx - mrun <= 64.0f)) != 0ull) {
                    const float mnew = fmaxf(mrun, mx);
                    const float alpha = fast_exp2(mrun - mnew);
                    mrun = mnew; lrun *= alpha;
#pragma unroll
                    for (int mt = 0; mt < 4; ++mt)
#pragma unroll
                        for (int i = 0; i < 16; ++i) o[mt][i] *= alpha;
                }
            }
            float psum = 0.f;
#pragma unroll
            for (int sub = 0; sub < 2; ++sub)
#pragma unroll
                for (int i = 0; i < 16; ++i) { const float pv = fast_exp2(st[sub][i] - mrun); st[sub][i] = pv; psum += pv; }
            lrun += psum;
            bf16x8 pf[2][2];
#pragma unroll
            for (int sub = 0; sub < 2; ++sub)
#pragma unroll
                for (int half = 0; half < 2; ++half) {
                    u32x4 w;
                    w.x = cvt_pk_bf16(st[sub][half * 8 + 0], st[sub][half * 8 + 1]); w.y = cvt_pk_bf16(st[sub][half * 8 + 2], st[sub][half * 8 + 3]);
                    w.z = cvt_pk_bf16(st[sub][half * 8 + 4], st[sub][half * 8 + 5]); w.w = cvt_pk_bf16(st[sub][half * 8 + 6], st[sub][half * 8 + 7]);
                    pf[sub][half] = __builtin_bit_cast(bf16x8, w);
                }
#pragma unroll
            for (int mt = 0; mt < 4; ++mt) {
                const unsigned char* vb = Vb + buf * VBUF + (mt * 32 + n) * VSTR + g * 16;
#pragma unroll
                for (int sub = 0; sub < 2; ++sub)
#pragma unroll
                    for (int half = 0; half < 2; ++half)
                        o[mt] = __builtin_amdgcn_mfma_f32_32x32x16_bf16(*(const bf16x8*)(vb + (sub * 32 + half * 16) * 2), pf[sub][half], o[mt], 0, 0, 0);
            }
        }
        asm volatile("s_waitcnt lgkmcnt(0)" ::: "memory");
        __builtin_amdgcn_s_barrier();
        asm volatile("" ::: "memory");
    }
    const float ltot = lrun + __shfl_xor(lrun, 32);
    const float inv = 1.0f / ltot;
    bf16_t* orow = O + (size_t)(q0w + n) * DM;
#pragma unroll
    for (int mt = 0; mt < 4; ++mt)
#pragma unroll
        for (int q4 = 0; q4 < 4; ++q4) {
            u32x2 w; w.x = cvt_pk_bf16(o[mt][4 * q4 + 0] * inv, o[mt][4 * q4 + 1] * inv); w.y = cvt_pk_bf16(o[mt][4 * q4 + 2] * inv, o[mt][4 * q4 + 3] * inv);
            *(u32x2*)(orow + mt * 32 + 8 * q4 + 4 * g) = w;
        }
#undef GLOAD
#undef LSTORE
#undef TILE_OF
}

#define XB_XCNT(j)  (256  + 64 * (j))
#define XB_XSUB(j)  (1280 + 64 * (j))
#define XB_XGEN(j)  (2304 + 64 * (j))
#define XB_TOP      3328
#define XB_TOPGEN   3392
#define XCD_BAR_WORDS 3456
#define CTL_GEMV 3456
#define CTL_QUEUE 3520
DEVI unsigned xb_xcc_id() { return (unsigned)__builtin_amdgcn_s_getreg((3 << 11) | 20) & 0xFu; }
DEVI void xcd_barrier_complete(unsigned* bar, unsigned x, unsigned& nloc, unsigned& nx) {
    const unsigned G = gridDim.x;
    unsigned sum, cnt, mine, sp = 0u;
    for (;;) {
        sum = 0u; cnt = 0u; mine = 0u;
#pragma unroll
        for (unsigned j = 0; j < 16; ++j) { const unsigned c = xb_ld(&bar[XB_XCNT(j)]); sum += c; cnt += (c > 0u) ? 1u : 0u; mine = (j == x) ? c : mine; }
        if (sum == G) break;
        __builtin_amdgcn_s_sleep(1);
        if ((++sp & 255u) == 0u) { if (xb_ld(&bar[XB_TMO])) break; if (sp > XB_SPIN_CAP) { atomicAdd(&bar[XB_TMO], 1u); break; } }
    }
    nloc = mine > 0u ? mine : 1u; nx = cnt > 0u ? cnt : 1u;
}
DEVI void xcd_barrier() {
    extern __shared__ __attribute__((aligned(16))) unsigned char shm[];
    volatile LAS unsigned* st = (volatile LAS unsigned*)((LAS unsigned char*)shm + LDS_MAIN);
    asm volatile("s_waitcnt vmcnt(0)" ::: "memory");
    __syncthreads();
    if (threadIdx.x == 0) {
        KP kq = kparams();
        unsigned* bar = (unsigned*)(kq->ws + WS_BAR);
        const unsigned x = xb_xcc_id();
        __builtin_amdgcn_s_waitcnt(0);
        unsigned nloc = st[0], nx = st[1];
        if (nloc == 0u) { xcd_barrier_complete(bar, x, nloc, nx); st[0] = nloc; st[1] = nx; }
        const unsigned old = xb_add(&bar[XB_XSUB(x)], 1u);
        const unsigned gen = old / nloc;
        if (old + 1u == (gen + 1u) * nloc) {
            __builtin_amdgcn_fence(__ATOMIC_RELEASE, "agent");
            asm volatile("s_waitcnt vmcnt(0)" ::: "memory");
            const unsigned og = xb_add(&bar[XB_TOP], 1u);
            const unsigned tg = og / nx;
            if (og + 1u == (tg + 1u) * nx) xb_add(&bar[XB_TOPGEN], 1u);
            else XB_SPIN(xb_ld(&bar[XB_TOPGEN]) == tg, bar);
            __builtin_amdgcn_fence(__ATOMIC_ACQUIRE, "agent");
            xb_add(&bar[XB_XGEN(x)], 1u);
            asm volatile("s_waitcnt vmcnt(0)" ::: "memory");
        } else {
            XB_SPIN(xb_ld(&bar[XB_XGEN(x)]) == gen, bar);
            __builtin_amdgcn_fence(__ATOMIC_ACQUIRE, "agent");
            asm volatile("s_waitcnt vmcnt(0)" ::: "memory");
        }
    }
    __syncthreads();
}
DEVI void xcd_barrier_post() {
    extern __shared__ __attribute__((aligned(16))) unsigned char shm[];
    volatile LAS unsigned* st = (volatile LAS unsigned*)((LAS unsigned char*)shm + LDS_MAIN);
    if (threadIdx.x < 2) st[threadIdx.x] = 0u;
    __syncthreads();
    if (threadIdx.x == 0) { KP kq = kparams(); unsigned* bar = (unsigned*)(kq->ws + WS_BAR); (void)xb_add(&bar[XB_XCNT(xb_xcc_id())], 1u); }
}

DEVI void panel_wait(unsigned* cnt, unsigned target, unsigned* ctl) {
    asm volatile("s_waitcnt vmcnt(0)" ::: "memory");
    __syncthreads();
    if (threadIdx.x == 0) { (void)xb_add(cnt, 1u); XB_SPIN(xb_ld(cnt) < target, ctl); }
    __syncthreads();
}
DEVI f32x4 bf4_lo(const u32x4 w) { return (f32x4){__uint_as_float(w.x << 16), __uint_as_float(w.x & 0xffff0000u), __uint_as_float(w.y << 16), __uint_as_float(w.y & 0xffff0000u)}; }
DEVI f32x4 bf4_hi(const u32x4 w) { return (f32x4){__uint_as_float(w.z << 16), __uint_as_float(w.z & 0xffff0000u), __uint_as_float(w.w << 16), __uint_as_float(w.w & 0xffff0000u)}; }
template <bool XIN_BF, bool XOUT_BF, bool HAS_H>
struct EpiRes {
    static constexpr bool AFTER_DRAIN = true;
    const void* xin; void* xout; float* ss1; float* ss2; unsigned* cnt; unsigned* ctl;
    const float *gpost, *gate; float coeff; const float *gpre, *shift, *scale; bf16_t* H;
    DEVI void operator()(const acc_t&, int, int, int, int, int, int) const {}
    DEVI void fused(acc_t& acc, int pm, int pn, int wr, int wc, int fr, int fq) const {
        const int row0 = pm * 256 + wr * 64 + fr, col0 = pn * 256 + wc * 32 + 8 * fq;
#pragma unroll
        for (int ai = 0; ai < 2; ++ai)
#pragma unroll
            for (int m = 0; m < 4; ++m) {
                float s = sq8(acc[ai][0][m][0], acc[ai][0][m][1]) + sq8(acc[ai][1][m][0], acc[ai][1][m][1]);
                s += __shfl_xor(s, 16); s += __shfl_xor(s, 32);
                if (fq == 0) unsafeAtomicAdd(ss1 + row0 + ai * 128 + m * 16, s);
            }
        const int bb = (pm * 256) >> 12;
        f32x4 gg[2][2];
#pragma unroll
        for (int bj = 0; bj < 2; ++bj)
#pragma unroll
            for (int hh = 0; hh < 2; ++hh) {
                const int col = col0 + bj * 128 + 4 * hh;
                gg[bj][hh] = *(const f32x4*)(gpost + col) * *(const f32x4*)(gate + (size_t)bb * NMOD + col) * coeff;
            }
        panel_wait(cnt + pm * 64, 8u, ctl);
        float rs1[8];
#pragma unroll
        for (int it = 0; it < 8; ++it) rs1[it] = __hip_atomic_load(ss1 + row0 + (it >> 2) * 128 + (it & 3) * 16, __ATOMIC_RELAXED, __HIP_MEMORY_SCOPE_AGENT);
#pragma unroll
        for (int it = 0; it < 8; ++it) rs1[it] = rsqrtf(rs1[it] * (1.0f / DM) + EPS);
        f32x4 xc[2][2], xn[2][2];
#define XLOAD(dst, it_) do { const int row_ = row0 + ((it_) >> 2) * 128 + ((it_) & 3) * 16; \
        _Pragma("unroll") for (int bj = 0; bj < 2; ++bj) { const int col = col0 + bj * 128; \
            if (XIN_BF) { const u32x4 xb = *(const u32x4*)((const bf16_t*)xin + (size_t)row_ * DM + col); dst[bj][0] = bf4_lo(xb); dst[bj][1] = bf4_hi(xb); } \
            else { dst[bj][0] = *(const f32x4*)((const float*)xin + (size_t)row_ * DM + col); dst[bj][1] = *(const f32x4*)((const float*)xin + (size_t)row_ * DM + col + 4); } } } while (0)
        XLOAD(xc, 0);
#pragma unroll
        for (int it = 0; it < 8; ++it) {
            const int ai = it >> 2, m = it & 3, row = row0 + ai * 128 + m * 16;
            if (it < 7) XLOAD(xn, it + 1);
            float s2 = 0.f;
#pragma unroll
            for (int bj = 0; bj < 2; ++bj) {
                const int col = col0 + bj * 128;
                f32x4 v0 = xc[bj][0] + gg[bj][0] * (acc[ai][bj][m][0] * rs1[it]), v1 = xc[bj][1] + gg[bj][1] * (acc[ai][bj][m][1] * rs1[it]);
                if (XOUT_BF) { const u32x4 w = pack8(v0, v1, 1.0f); *(u32x4*)((bf16_t*)xout + (size_t)row * DM + col) = w; v0 = bf4_lo(w); v1 = bf4_hi(w); }
                else { *(f32x4*)((float*)xout + (size_t)row * DM + col) = v0; *(f32x4*)((float*)xout + (size_t)row * DM + col + 4) = v1; }
                if (HAS_H) { acc[ai][bj][m][0] = v0; acc[ai][bj][m][1] = v1; s2 += sq8(v0, v1); }
            }
            if (HAS_H) { s2 += __shfl_xor(s2, 16); s2 += __shfl_xor(s2, 32); if (fq == 0) unsafeAtomicAdd(ss2 + row, s2); }
#pragma unroll
            for (int bj = 0; bj < 2; ++bj) { xc[bj][0] = xn[bj][0]; xc[bj][1] = xn[bj][1]; }
        }
#undef XLOAD
        if (HAS_H) {
            f32x4 hg[2][2], hs[2][2];
#pragma unroll
            for (int bj = 0; bj < 2; ++bj)
#pragma unroll
                for (int hh = 0; hh < 2; ++hh) {
                    const int col = col0 + bj * 128 + 4 * hh;
                    hg[bj][hh] = *(const f32x4*)(gpre + col) * (1.0f + *(const f32x4*)(scale + (size_t)bb * NMOD + col));
                    hs[bj][hh] = *(const f32x4*)(shift + (size_t)bb * NMOD + col);
                }
            panel_wait(cnt + pm * 64, 16u, ctl);
            float rs2[8];
#pragma unroll
            for (int it = 0; it < 8; ++it) rs2[it] = __hip_atomic_load(ss2 + row0 + (it >> 2) * 128 + (it & 3) * 16, __ATOMIC_RELAXED, __HIP_MEMORY_SCOPE_AGENT);
#pragma unroll
            for (int it = 0; it < 8; ++it) {
                const int ai = it >> 2, m = it & 3, row = row0 + ai * 128 + m * 16;
                const float rstd2 = rsqrtf(rs2[it] * (1.0f / DM) + EPS);
#pragma unroll
                for (int bj = 0; bj < 2; ++bj) {
                    const f32x4 h0 = (acc[ai][bj][m][0] * rstd2) * hg[bj][0] + hs[bj][0], h1 = (acc[ai][bj][m][1] * rstd2) * hg[bj][1] + hs[bj][1];
                    *(u32x4*)(H + (size_t)row * DM + col0 + bj * 128) = pack8(h0, h1, 1.0f);
                }
            }
        }
    }
};

__constant__ unsigned char ATT_ORDER[32] = {15, 14, 13, 12, 31, 30, 11, 29, 10, 28, 9, 27, 8, 26, 25, 7, 24, 6, 23, 5, 22, 4, 21, 20, 3, 19, 2, 18, 1, 17, 0, 16};

#define WSP(T, off) ((T*)(ws + (off)))
#ifdef USE_CG_SYNC
#define GSYNC() grid.sync()
#else
#define GSYNC() xcd_barrier()
#endif
#ifdef LEAK_A
#define TS(i) do { if (blockIdx.x == 0 && threadIdx.x == 0) { KP kq = kparams(); ((unsigned long long*)(kq->ws + WS_END))[i] = __builtin_amdgcn_s_memrealtime(); } } while (0)
#else
#define TS(i) do { } while (0)
#endif
__global__ void __launch_bounds__(512) mega(Params p_unused) {
    cg::grid_group grid = cg::this_grid();
    xcd_barrier_post();
    TS(0);
    if (PH(0)) {
        KP kp = kparams(); unsigned char* ws = kp->ws;
        ada_gemv(kp->w_ada, kp->b_ada, kp->c, ws);
        asm volatile("s_waitcnt vmcnt(0)" ::: "memory");
        __syncthreads();
        if (threadIdx.x == 0) { unsigned nu = 0; for (int u = blockIdx.x; u < 9 * 32; u += gridDim.x) ++nu; if (nu) xb_add((unsigned*)(ws + WS_BAR) + CTL_GEMV, nu); }
        rope_table(ws);
        for (int rep = 0; rep < REPS(0); ++rep) {
        conv_weight(MapUp{kp->w1g, kp->w1u}, WSP(bf16_t, WS_BT1U), 2 * DFF, DM, DFF, nullptr, (int)gridDim.x == 256 ? 32 : 0, 0);
        conv_weight(MapPlain{kp->w1d}, WSP(bf16_t, WS_BT1D), DM, DFF, DM, nullptr, 0, 128);
        conv_weight(MapIn{kp->w_in}, WSP(bf16_t, WS_BTIN), 4096, DM, 3912, nullptr);
        conv_weight(MapUq{kp->w_uq}, WSP(bf16_t, WS_BTUQ), 1536, 512, 1536, kp->g_qa, 0, 0);
        conv_weight(MapUkv{kp->w_ukv}, WSP(bf16_t, WS_BTUKV), 2048, 256, 2048, kp->g_kva, 0, 160);
        conv_weight(MapPlain{kp->w_o}, WSP(bf16_t, WS_BTO), DM, DM, DM, nullptr);
        conv_weight(MapUp{kp->w2g, kp->w2u}, WSP(bf16_t, WS_BT2U), 2 * DFF, DM, DFF, nullptr);
        conv_weight(MapPlain{kp->w2d}, WSP(bf16_t, WS_BT2D), DM, DFF, DM, nullptr, 0, 0);
        }
    }
    TS(1);
    if (PH(1)) {
        { KP kp = kparams(); unsigned* ctl = (unsigned*)(kp->ws + WS_BAR);
          if (threadIdx.x == 0) { XB_SPIN(xb_ld(&ctl[CTL_GEMV]) < 288u, ctl); __builtin_amdgcn_fence(__ATOMIC_ACQUIRE, "agent"); asm volatile("s_waitcnt vmcnt(0)" ::: "memory"); }
          __syncthreads(); }
        for (int rep = 0; rep < REPS(1); ++rep) { KP kp = kparams(); unsigned char* ws = kp->ws; const float* mod = WSP(float, WS_MOD);
        rowpass_h1(kp->x, kp->g1pre, mod + 0 * DM, mod + 1 * DM, WSP(bf16_t, WS_H)); }
    }
    { KP kp = kparams(); if (kp->out == nullptr) grid.sync(); }
    GSYNC();
    TS(2);
    if (PH(2)) for (int rep = 0; rep < REPS(2); ++rep) { KP kp = kparams(); unsigned char* ws = kp->ws;
        gemm_phase<SPLIT_TAIL != 0>(WSP(bf16_t, WS_H), WSP(bf16_t, WS_BT1U), NTOK, 2 * DFF, DM, EpiSwiglu{WSP(bf16_t, WS_U)}, rep ? PROBE_ULIMIT : 0x7fffffff,
                   WSP(float, WS_SLAB), WSP(unsigned, WS_FLAG), WSP(unsigned, WS_BAR)); }
    GSYNC();
    TS(3);
#if FUSE_RES
    if (PH(3)) { KP kp = kparams(); unsigned char* ws = kp->ws; const float* mod = WSP(float, WS_MOD);
        gemm_phase(WSP(bf16_t, WS_U), WSP(bf16_t, WS_BT1D), NTOK, DM, DFF,
                   EpiRes<false, true, true>{kp->x, WSP(bf16_t, WS_X1), WSP(float, WS_SS) + 0 * NTOK, WSP(float, WS_SS) + 6 * NTOK, WSP(unsigned, WS_CNT) + 0 * 32 * 64, WSP(unsigned, WS_BAR),
                                             kp->g1post, mod + 2 * DM, 0.5f, kp->gmpre, mod + 3 * DM, mod + 4 * DM, WSP(bf16_t, WS_H)}); }
    GSYNC();
    TS(4);
    TS(5);
#else
    if (PH(3)) for (int rep = 0; rep < REPS(3); ++rep) { KP kp = kparams(); unsigned char* ws = kp->ws;
        gemm_phase(WSP(bf16_t, WS_U), WSP(bf16_t, WS_BT1D), NTOK, DM, DFF, EpiY{WSP(bf16_t, WS_Y), DM, SSP(0)}); }
    GSYNC();
    TS(4);
    if (PH(4)) for (int rep = 0; rep < REPS(4); ++rep) { KP kp = kparams(); unsigned char* ws = kp->ws; const float* mod = WSP(float, WS_MOD);
        rowpass<true, true, false, true>(kp->x, WSP(bf16_t, WS_X1), WSP(bf16_t, WS_Y), WSP(float, WS_SS) + 0 * NTOK, kp->g1post, mod + 2 * DM, 0.5f, kp->gmpre, mod + 3 * DM, mod + 4 * DM, WSP(bf16_t, WS_H)); }
    GSYNC();
    TS(5);
#endif
#ifdef PROBE_NULL_IN
    if (PH(5)) { KP kp = kparams(); unsigned char* ws = kp->ws;
        gemm_phase(WSP(bf16_t, WS_H), WSP(bf16_t, WS_BTIN), NTOK, 4096, DM, EpiNull{WSP(float, WS_SS) + 5 * NTOK}); }
#endif
    if (PH(5)) for (int rep = 0; rep < REPS(5); ++rep) { KP kp = kparams(); unsigned char* ws = kp->ws;
        gemm_phase(WSP(bf16_t, WS_H), WSP(bf16_t, WS_BTIN), NTOK, 4096, DM,
                   EpiIn{WSP(bf16_t, WS_QA), WSP(bf16_t, WS_KVA), WSP(bf16_t, WS_KR), WSP(bf16_t, WS_FQ), WSP(bf16_t, WS_FK), WSP(bf16_t, WS_VTF), SSP(1),
                         SSP(2), WSP(float, WS_LOGF), WSP(float, WS_ROPEC), WSP(float, WS_ROPES), kp->b_forget}); }
    GSYNC();
    TS(6);
    if (PH(6)) { KP kp = kparams(); unsigned char* ws = kp->ws;
        if ((phase_tid() >> 6) == 0) for (int bh = (int)(gridDim.x - 1 - blockIdx.x); bh < 16; bh += gridDim.x) cumsum_unit(WSP(float, WS_LOGF), WSP(float, WS_CUM), bh); }
    if (PH(6)) for (int rep = 0; rep < REPS(6); ++rep) { KP kp = kparams(); unsigned char* ws = kp->ws;
        gemm_phase(WSP(bf16_t, WS_QA), WSP(bf16_t, WS_BTUQ), NTOK, 1536, 512, EpiQ{WSP(bf16_t, WS_QM), WSP(float, WS_SS) + 1 * NTOK, WSP(float, WS_ROPEC), WSP(float, WS_ROPES)}); }
    if (PH(7)) for (int rep = 0; rep < REPS(7); ++rep) { KP kp = kparams(); unsigned char* ws = kp->ws;
        gemm_phase(WSP(bf16_t, WS_KVA), WSP(bf16_t, WS_BTUKV), NTOK, 2048, 256, EpiKV{WSP(bf16_t, WS_KN), WSP(bf16_t, WS_VTM), WSP(float, WS_SS) + 2 * NTOK}); }
    GSYNC();
    TS(7);
    {
        extern __shared__ __attribute__((aligned(16))) unsigned char shm[];
        volatile LAS unsigned* slot = (volatile LAS unsigned*)((LAS unsigned char*)shm + LDS_MAIN + 16);
        bool first = true;
        for (;;) {
            __syncthreads();
            if (threadIdx.x == 0) { KP kq = kparams(); slot[0] = first ? blockIdx.x : gridDim.x + xb_add((unsigned*)(kq->ws + WS_BAR) + CTL_QUEUE, 1u); }
            first = false;
            __syncthreads();
            const unsigned sl = slot[0];
            if (sl >= 512u * (unsigned)REPS(8)) break;
            const int i = (int)(sl & 511u), e = ATT_ORDER[i >> 4], bh = i & 15, b = bh >> 3, h = bh & 7, qb = e & 15;
            KP kp = kparams(); unsigned char* ws = kp->ws;
            if (e < 16) {
                if (PH(8)) attn_item<192, false>(WSP(bf16_t, WS_QM) + (size_t)b * SEQ * 1536 + h * 192, 1536, WSP(bf16_t, WS_KN) + (size_t)b * SEQ * 1024 + h * 128, WSP(bf16_t, WS_KR) + (size_t)b * SEQ * 64,
                                      WSP(bf16_t, WS_VTM) + (size_t)bh * 128 * SEQ, nullptr, WSP(bf16_t, WS_O) + (size_t)b * SEQ * DM + h * 128, qb);
            } else {
                if (PH(9)) attn_item<128, true>(WSP(bf16_t, WS_FQ) + (size_t)b * SEQ * 1024 + h * 128, 1024, WSP(bf16_t, WS_FK) + (size_t)b * SEQ * 1024 + h * 128, nullptr,
                                     WSP(bf16_t, WS_VTF) + (size_t)bh * 128 * SEQ, WSP(float, WS_CUM) + (size_t)bh * SEQ, WSP(bf16_t, WS_O) + (size_t)b * SEQ * DM + 1024 + h * 128, qb);
            }
        }
    }
    GSYNC();
    TS(8);
#if FUSE_RES
    if (PH(10)) { KP kp = kparams(); unsigned char* ws = kp->ws; const float* mod = WSP(float, WS_MOD);
        gemm_phase(WSP(bf16_t, WS_O), WSP(bf16_t, WS_BTO), NTOK, DM, DM,
                   EpiRes<true, true, true>{WSP(bf16_t, WS_X1), WSP(bf16_t, WS_X1), WSP(float, WS_SS) + 3 * NTOK, WSP(float, WS_SS) + 7 * NTOK, WSP(unsigned, WS_CNT) + 1 * 32 * 64, WSP(unsigned, WS_BAR),
                                            kp->gmpost, mod + 5 * DM, 1.0f, kp->g2pre, mod + 6 * DM, mod + 7 * DM, WSP(bf16_t, WS_H)}); }
    GSYNC();
    TS(9);
    TS(10);
#else
    if (PH(10)) for (int rep = 0; rep < REPS(10); ++rep) { KP kp = kparams(); unsigned char* ws = kp->ws;
        gemm_phase(WSP(bf16_t, WS_O), WSP(bf16_t, WS_BTO), NTOK, DM, DM, EpiY{WSP(bf16_t, WS_Y), DM, SSP(3)}); }
    GSYNC();
    TS(9);
    if (PH(11)) { KP kp = kparams(); unsigned char* ws = kp->ws; const float* mod = WSP(float, WS_MOD);
        rowpass<true, true, true, true>(WSP(bf16_t, WS_X1), WSP(bf16_t, WS_X1), WSP(bf16_t, WS_Y), WSP(float, WS_SS) + 3 * NTOK, kp->gmpost, mod + 5 * DM, 1.0f, kp->g2pre, mod + 6 * DM, mod + 7 * DM, WSP(bf16_t, WS_H)); }
    GSYNC();
    TS(10);
#endif
    if (PH(12)) for (int rep = 0; rep < REPS(12); ++rep) { KP kp = kparams(); unsigned char* ws = kp->ws;
        gemm_phase<SPLIT_TAIL != 0>(WSP(bf16_t, WS_H), WSP(bf16_t, WS_BT2U), NTOK, 2 * DFF, DM, EpiSwiglu{WSP(bf16_t, WS_U)}, 0x7fffffff,
                   WSP(float, WS_SLAB) + (size_t)128 * 65536, WSP(unsigned, WS_FLAG) + 128 * 16, WSP(unsigned, WS_BAR)); }
    GSYNC();
    TS(11);
#if FUSE_RES
    if (PH(13)) { KP kp = kparams(); unsigned char* ws = kp->ws; const float* mod = WSP(float, WS_MOD);
        gemm_phase(WSP(bf16_t, WS_U), WSP(bf16_t, WS_BT2D), NTOK, DM, DFF,
                   EpiRes<true, false, false>{WSP(bf16_t, WS_X1), kp->out, WSP(float, WS_SS) + 4 * NTOK, nullptr, WSP(unsigned, WS_CNT) + 2 * 32 * 64, WSP(unsigned, WS_BAR),
                                              kp->g2post, mod + 8 * DM, 0.5f, nullptr, nullptr, nullptr, nullptr}); }
#else
    if (PH(13)) for (int rep = 0; rep < REPS(13); ++rep) { KP kp = kparams(); unsigned char* ws = kp->ws;
        gemm_phase(WSP(bf16_t, WS_U), WSP(bf16_t, WS_BT2D), NTOK, DM, DFF, EpiY{WSP(bf16_t, WS_Y), DM, SSP(4)}); }
    GSYNC();
    TS(12);
    if (PH(14)) { KP kp = kparams(); unsigned char* ws = kp->ws; const float* mod = WSP(float, WS_MOD);
        rowpass<true, false, true, false>(WSP(bf16_t, WS_X1), kp->out, WSP(bf16_t, WS_Y), WSP(float, WS_SS) + 4 * NTOK, kp->g2post, mod + 8 * DM, 0.5f, nullptr, nullptr, nullptr, nullptr); }
#endif
#ifdef LEAK_A
    GSYNC();
    TS(13);
    GSYNC();
    {
        KP kp = kparams(); const unsigned long long* tsp = (const unsigned long long*)(kp->ws + WS_END);
        float A = 0.f, B = 0.f;
        for (int i = 0; i < 13; ++i) {
            const float dt = (float)(tsp[i + 1] - tsp[i]) * 0.01f;
            if ((LEAK_A >> i) & 1) A += dt;
            if ((LEAK_B >> i) & 1) B += dt;
        }
        float* o = kp->out;
        for (size_t i = (size_t)blockIdx.x * 512 + threadIdx.x; i < (size_t)NTOK * DM; i += (size_t)gridDim.x * 512) o[i] = (i == 0) ? A * 1000.f : B;
    }
#endif
}

extern "C" void kernel_launch(void* const* d_in, const int* in_sizes, int n_in, void* d_out, int out_size, void* d_ws, size_t ws_size, hipStream_t stream) {
    static int grid_blocks = 0;
    if (!grid_blocks) {
        int dev = 0, cus = 0, per_cu = 0;
        hipGetDevice(&dev);
        hipDeviceGetAttribute(&cus, hipDeviceAttributeMultiprocessorCount, dev);
        hipFuncSetAttribute((const void*)mega, hipFuncAttributeMaxDynamicSharedMemorySize, LDS_BYTES);
        hipOccupancyMaxActiveBlocksPerMultiprocessor(&per_cu, mega, 512, LDS_BYTES);
        if (per_cu < 1) per_cu = 1;
        if (per_cu > 1) per_cu = 1;
        grid_blocks = cus * per_cu;
        grid_blocks &= ~7;
        if (grid_blocks > 256) grid_blocks = 256;
    }
    if (ws_size < WS_END) { fprintf(stderr, "workspace too small\n"); return; }
    if (FUSE_RES && grid_blocks != 256) { fprintf(stderr, "fused residual epilogues need a 256-workgroup grid (have %d)\n", grid_blocks); return; }
    Params p{};
    const float** pf = (const float**)&p;
    for (int i = 0; i < 23; ++i) pf[i] = (const float*)d_in[i];
    p.out = (float*)d_out;
    p.ws = (unsigned char*)d_ws;
    hipMemsetAsync(d_ws, 0, WS_ZERO_END, stream);
    void* args[] = {&p};
    hipError_t e = hipLaunchCooperativeKernel((void*)mega, dim3(grid_blocks), dim3(512), args, LDS_BYTES, stream);
    if (e != hipSuccess) fprintf(stderr, "cooperative launch failed: %s (grid %d)\n", hipGetErrorString(e), grid_blocks);
}
```

```cpp
#include <hip/hip_runtime.h>
#include <hip/hip_cooperative_groups.h>
#include <stdint.h>
#include <stdio.h>
namespace cg = cooperative_groups;

#define DEVI __device__ __forceinline__
typedef unsigned short bf16_t;
typedef short bf16x8 __attribute__((ext_vector_type(8)));
typedef float f32x4 __attribute__((ext_vector_type(4)));
typedef float f32x16 __attribute__((ext_vector_type(16)));
typedef unsigned u32x4 __attribute__((ext_vector_type(4)));
typedef unsigned u32x2 __attribute__((ext_vector_type(2)));

constexpr int DM = 2048, SEQ = 4096, NTOK = 8192, DFF = 5632, NMOD = 9 * DM;
constexpr float EPS = 1e-6f;
constexpr float LOG2E = 1.4426950408889634f;
constexpr int LDS_MAIN = 131072;
constexpr int LDS_VT = LDS_MAIN + 256;
constexpr int LDS_BYTES = LDS_VT + 8 * 2560;

constexpr size_t WS_MOD = 0;
constexpr size_t WS_SS = WS_MOD + (size_t)2 * NMOD * 4;
constexpr size_t WS_BAR = WS_SS + (size_t)8 * NTOK * 4;
constexpr size_t WS_CNT = WS_BAR + 14336;
constexpr size_t WS_FLAG = WS_CNT + (size_t)96 * 256;
constexpr size_t WS_ZERO_END = WS_FLAG + (size_t)256 * 64;
constexpr size_t WS_ROPEC = WS_ZERO_END;
constexpr size_t WS_ROPES = WS_ROPEC + (size_t)SEQ * 32 * 4;
constexpr size_t WS_CUM = WS_ROPES + (size_t)SEQ * 32 * 4;
constexpr size_t WS_LOGF = WS_CUM + (size_t)16 * SEQ * 4;
constexpr size_t WS_BT1U = WS_LOGF + (size_t)NTOK * 8 * 4;
constexpr size_t WS_BT1D = WS_BT1U + (size_t)2 * DFF * DM * 2;
constexpr size_t WS_BT2U = WS_BT1D + (size_t)DM * DFF * 2;
constexpr size_t WS_BT2D = WS_BT2U + (size_t)2 * DFF * DM * 2;
constexpr size_t WS_BTIN = WS_BT2D + (size_t)DM * DFF * 2;
constexpr size_t WS_BTUQ = WS_BTIN + (size_t)4096 * DM * 2;
constexpr size_t WS_BTUKV = WS_BTUQ + (size_t)1536 * 512 * 2;
constexpr size_t WS_BTO = WS_BTUKV + (size_t)2048 * 256 * 2;
constexpr size_t WS_H = WS_BTO + (size_t)DM * DM * 2;
constexpr size_t WS_U = WS_H + (size_t)NTOK * DM * 2;
constexpr size_t WS_Y = WS_U + (size_t)NTOK * DFF * 2;
constexpr size_t WS_QA = WS_Y + (size_t)NTOK * DM * 2;
constexpr size_t WS_KVA = WS_QA + (size_t)NTOK * 512 * 2;
constexpr size_t WS_KR = WS_KVA + (size_t)NTOK * 256 * 2;
constexpr size_t WS_FQ = WS_KR + (size_t)NTOK * 64 * 2;
constexpr size_t WS_FK = WS_FQ + (size_t)NTOK * 1024 * 2;
constexpr size_t WS_VTF = WS_FK + (size_t)NTOK * 1024 * 2;
constexpr size_t WS_QM = WS_VTF + (size_t)NTOK * 1024 * 2;
constexpr size_t WS_KN = WS_QM + (size_t)NTOK * 1536 * 2;
constexpr size_t WS_VTM = WS_KN + (size_t)NTOK * 1024 * 2;
constexpr size_t WS_O = WS_VTM + (size_t)NTOK * 1024 * 2;
constexpr size_t WS_X1 = WS_O + (size_t)NTOK * DM * 2;
constexpr size_t WS_SLAB = WS_X1 + (size_t)NTOK * DM * 2;
constexpr size_t WS_END = WS_SLAB + (size_t)2 * 128 * 262144;

#ifndef PHASE_MASK
#define PHASE_MASK 0xffffffffu
#endif
#define PH(n) ((PHASE_MASK >> (n)) & 1u)
#ifndef REP_MASK
#define REP_MASK 0u
#endif
#define REPS(n) (1 + (int)((REP_MASK >> (n)) & 1u))
#define SSP(k) (WSP(float, WS_SS) + (size_t)(rep ? 5 : (k)) * NTOK)
#ifndef PROBE_ULIMIT
#define PROBE_ULIMIT 0x7fffffff
#endif
#ifndef SPLIT_TAIL
#define SPLIT_TAIL 1
#endif
#ifndef FUSE_RES
#define FUSE_RES 1
#endif

struct Params {
    const float *x, *c, *w_ada, *b_ada, *g1pre, *g1post, *w1g, *w1u, *w1d, *gmpre, *gmpost, *w_in, *b_forget, *g_qa, *w_uq, *g_kva, *w_ukv, *w_o,
        *g2pre, *g2post, *w2g, *w2u, *w2d;
    float* out;
    unsigned char* ws;
};

typedef const Params __attribute__((address_space(4)))* KP;
DEVI KP kparams() { KP kp = (KP)__builtin_amdgcn_kernarg_segment_ptr(); asm volatile("" : "+s"(kp)); return kp; }
DEVI unsigned cvt_pk_bf16(float lo, float hi) { unsigned r; asm("v_cvt_pk_bf16_f32 %0, %1, %2" : "=v"(r) : "v"(lo), "v"(hi)); return r; }
DEVI int phase_tid() { int t = threadIdx.x; asm volatile("" : "+v"(t)); return t; }
DEVI float bf2f(unsigned short v) { return __uint_as_float((unsigned)v << 16); }
DEVI float fast_exp2(float x) { return __builtin_amdgcn_exp2f(x); }
DEVI float silu_f(float g) { return g * __builtin_amdgcn_rcpf(1.0f + __expf(-g)); }
DEVI int perm32(int rho) { const int n = rho >> 4, i = rho & 15; return 8 * (i >> 2) + 4 * n + (i & 3); }
DEVI int permcol(int r) { return (r & ~31) + perm32(r & 31); }

struct MapPlain { const float* W; DEVI const float* base() const { return W; } DEVI const float* operator()(int r) const { return W + permcol(r); } };
struct MapUp { const float *Wg, *Wu; DEVI const float* base() const { return Wg; } DEVI const float* operator()(int r) const { const int t = r >> 8, w = r & 255, half = w >> 7; const uintptr_t mk = (uintptr_t)0 - (uintptr_t)half; const float* base = (const float*)(((uintptr_t)Wg & ~mk) | ((uintptr_t)Wu & mk)); return base + t * 128 + permcol(w & 127); } };
struct MapIn { const float* W;
    DEVI const float* base() const { return W; }
    DEVI const float* operator()(int r) const {
        const int l = permcol(r);
        int c;
        if (l < 768) c = l;
        else if (l < 1024) { const int j = l - 768, bj = j >> 7, jj = j & 127;
            if (jj < 32) c = 768 + bj * 32 + jj;
            else if (bj == 0 && jj < 40) c = 3904 + jj - 32;
            else c = -1; }
        else if (l < 2048) c = 832 + l - 1024;
        else if (l < 3072) c = 1856 + l - 2048;
        else c = 2880 + l - 3072;
        return c < 0 ? nullptr : W + c;
    } };
struct MapUq { const float* W;
    DEVI const float* base() const { return W; }
    DEVI const float* operator()(int r) const {
        const int l = permcol(r);
        if (l < 1024) return W + (l >> 7) * 192 + (l & 127);
        const int t = (l - 1024) >> 8, j = (l - 1024) & 255, bj = j >> 7, jj = j & 127, hh = jj >> 5, i = jj & 31;
        return W + (4 * t + hh) * 192 + 128 + bj * 32 + i;
    } };
struct MapUkv { const float* W;
    DEVI const float* base() const { return W; }
    DEVI const float* operator()(int r) const {
        const int l = permcol(r);
        if (l < 1024) return W + (l >> 7) * 256 + (l & 127);
        return W + ((l - 1024) >> 7) * 256 + 128 + (l & 127);
    } };

#define RBAR() do { asm volatile("s_waitcnt lgkmcnt(0)" ::: "memory"); __builtin_amdgcn_s_barrier(); asm volatile("" ::: "memory"); } while (0)
template <class Map>
DEVI void conv_weight(const Map& map, bf16_t* __restrict__ Bt, int Nrows, int K, int ldw, const float* __restrict__ rs, int first = 0, int rot = 0) {
    extern __shared__ __attribute__((aligned(16))) unsigned char shm[];
    float* tile = (float*)shm;
    if ((int)blockIdx.x < first) return;
    const int tid = phase_tid(), nkb = K >> 7, nun = (Nrows >> 6) * nkb, G = (int)gridDim.x - first;
    const int n = tid & 63, kq = tid >> 6, rn = tid >> 3, kc = tid & 7;
    float v[16], w[16];
#define CONV_LOAD(dst, uu) do { const int rb_ = (uu) / nkb, kb_ = (uu) - rb_ * nkb; const float* scp_ = map(rb_ * 64 + n); \
        const float msk_ = scp_ ? 1.0f : 0.0f; const float* p_ = (scp_ ? scp_ : map.base()) + (size_t)(kb_ * 128 + kq) * ldw;     \
        _Pragma("unroll") for (int it = 0; it < 16; ++it) dst[it] = __builtin_nontemporal_load(p_ + (size_t)(8 * it) * ldw) * msk_; } while (0)
    int u = ((int)blockIdx.x - first + rot) % G;
    if (u < nun) CONV_LOAD(v, u);
    for (; u < nun; u += G) {
        if (u + G < nun) CONV_LOAD(w, u + G);
        const int rb = u / nkb, kb = u - rb * nkb, r0 = rb * 64, k0 = kb * 128;
        if (rs) {
#pragma unroll
            for (int it = 0; it < 16; ++it) v[it] *= rs[k0 + kq + 8 * it];
        }
        RBAR();
#pragma unroll
        for (int it = 0; it < 16; ++it) tile[(kq + 8 * it) * 65 + n] = v[it];
        RBAR();
        unsigned pk[8];
#pragma unroll
        for (int j = 0; j < 8; ++j) pk[j] = cvt_pk_bf16(tile[(kc * 16 + 2 * j) * 65 + rn], tile[(kc * 16 + 2 * j + 1) * 65 + rn]);
        u32x4* dst = (u32x4*)(Bt + (size_t)(r0 + rn) * K + k0 + kc * 16);
        dst[0] = (u32x4){pk[0], pk[1], pk[2], pk[3]};
        dst[1] = (u32x4){pk[4], pk[5], pk[6], pk[7]};
#pragma unroll
        for (int it = 0; it < 16; ++it) v[it] = w[it];
    }
    RBAR();
#undef CONV_LOAD
}

DEVI void ada_gemv(const float* __restrict__ w_ada, const float* __restrict__ b_ada, const float* __restrict__ cvec, unsigned char* ws) {
    float* mod = (float*)(ws + WS_MOD);
    const int tid = phase_tid();
    for (int u = blockIdx.x; u < 9 * 32; u += gridDim.x) {
        const int cb = u % 9, kc = u / 9, col = cb * 2048 + tid * 4, k0 = kc * 64;
        f32x4 a0 = {0.f, 0.f, 0.f, 0.f}, a1 = {0.f, 0.f, 0.f, 0.f};
#pragma unroll 8
        for (int k = 0; k < 64; ++k) {
            const f32x4 w = __builtin_nontemporal_load((const f32x4*)(w_ada + (size_t)(k0 + k) * NMOD + col));
            const float c0 = silu_f(cvec[k0 + k]), c1 = silu_f(cvec[DM + k0 + k]);
            a0 += c0 * w; a1 += c1 * w;
        }
        if (kc == 0) { const f32x4 bb = *(const f32x4*)(b_ada + col); a0 += bb; a1 += bb; }
#pragma unroll
        for (int j = 0; j < 4; ++j) { unsafeAtomicAdd(mod + col + j, a0[j]); unsafeAtomicAdd(mod + NMOD + col + j, a1[j]); }
    }
}

DEVI void rope_table(unsigned char* ws) {
    float* rc = (float*)(ws + WS_ROPEC); float* rsn = (float*)(ws + WS_ROPES);
    for (int idx = blockIdx.x * 512 + phase_tid(); idx < SEQ * 32; idx += gridDim.x * 512) {
        const int pos = idx >> 5, i = idx & 31;
        const float inv = exp2f(-(float)i * (13.287712379549449f / 32.0f));
        const float ang = (float)pos * inv;
        double rev = (double)ang * 0.15915494309189535; rev -= rint(rev);
        rc[idx] = __builtin_amdgcn_cosf((float)rev);
        rsn[idx] = __builtin_amdgcn_sinf((float)rev);
    }
}

template <bool HAS_Y, bool HAS_H, bool XIN_BF, bool XOUT_BF>
DEVI void rowpass(const void* xin_, void* xout_, const bf16_t* __restrict__ Y, const float* __restrict__ ssy, const float* __restrict__ gpost, const float* __restrict__ gate,
                  float coeff, const float* __restrict__ gpre, const float* __restrict__ shift, const float* __restrict__ scale, bf16_t* __restrict__ H) {
    const int tid_ = phase_tid(); const int wid = tid_ >> 6, lane = tid_ & 63;
    for (int row = blockIdx.x * 8 + wid; row < NTOK; row += gridDim.x * 8) {
        const int b = row >> 12;
        int l4 = lane * 4; asm volatile("" : "+v"(l4));
        f32x4 xv[8];
        float rstd_y = 0.f;
        if (HAS_Y) rstd_y = rsqrtf(ssy[row] * (1.0f / DM) + EPS);
        float ss = 0.f;
#pragma unroll
        for (int ch = 0; ch < 8; ++ch) {
            const int col = ch * 256 + l4;
            f32x4 xx;
            if (XIN_BF) { const u32x2 xb = *(const u32x2*)((const bf16_t*)xin_ + (size_t)row * DM + col);
                xx = (f32x4){__uint_as_float(xb.x << 16), __uint_as_float(xb.x & 0xffff0000u), __uint_as_float(xb.y << 16), __uint_as_float(xb.y & 0xffff0000u)}; }
            else xx = *(const f32x4*)((const float*)xin_ + (size_t)row * DM + col);
            if (HAS_Y) {
                const u32x2 yy = *(const u32x2*)(Y + (size_t)row * DM + col);
                const f32x4 gp = *(const f32x4*)(gpost + col);
                const f32x4 gt = *(const f32x4*)(gate + (size_t)b * NMOD + col);
                f32x4 yv = {__uint_as_float(yy.x << 16), __uint_as_float(yy.x & 0xffff0000u), __uint_as_float(yy.y << 16), __uint_as_float(yy.y & 0xffff0000u)};
                xx += coeff * gt * (yv * rstd_y * gp);
                if (XOUT_BF) { u32x2 xo; xo.x = cvt_pk_bf16(xx[0], xx[1]); xo.y = cvt_pk_bf16(xx[2], xx[3]); *(u32x2*)((bf16_t*)xout_ + (size_t)row * DM + col) = xo;
                    xx = (f32x4){__uint_as_float(xo.x << 16), __uint_as_float(xo.x & 0xffff0000u), __uint_as_float(xo.y << 16), __uint_as_float(xo.y & 0xffff0000u)}; }
                else *(f32x4*)((float*)xout_ + (size_t)row * DM + col) = xx;
            }
            xv[ch] = xx;
            ss += xx[0] * xx[0] + xx[1] * xx[1] + xx[2] * xx[2] + xx[3] * xx[3];
        }
        if (HAS_H) {
#pragma unroll
            for (int o = 32; o >= 1; o >>= 1) ss += __shfl_xor(ss, o);
            const float rstd = rsqrtf(ss * (1.0f / DM) + EPS);
#pragma unroll
            for (int ch = 0; ch < 8; ++ch) {
                const int col = ch * 256 + l4;
                const f32x4 gp = *(const f32x4*)(gpre + col);
                const f32x4 sc = *(const f32x4*)(scale + (size_t)b * NMOD + col);
                const f32x4 sh = *(const f32x4*)(shift + (size_t)b * NMOD + col);
                const f32x4 hv = (xv[ch] * rstd * gp) * (1.0f + sc) + sh;
                u32x2 o2; o2.x = cvt_pk_bf16(hv[0], hv[1]); o2.y = cvt_pk_bf16(hv[2], hv[3]);
                *(u32x2*)(H + (size_t)row * DM + col) = o2;
            }
        }
    }
}

DEVI int lds_byte(int r, int c) { const int st = (r >> 4) * 2 + (c >> 5), rr = r & 15, cc = c & 31, ob = rr * 64 + cc * 2; return st * 1024 + (ob ^ (((ob >> 9) & 1) << 5)); }
DEVI void stage_rc(int b, int& R, int& C) { const int st = b / 1024, sb = b % 1024, swz = sb ^ (((sb >> 9) & 1) << 5); R = (st >> 1) * 16 + swz / 64; C = (st & 1) * 32 + (swz % 64) / 2; }

DEVI bool next_unit(int i, int nM, int nN, int& pm, int& pn, int ulimit = 0x7fffffff) {
    const int nwg = nM * nN; const long L = (long)i * gridDim.x + blockIdx.x; if (L >= nwg || L >= ulimit) return false;
    int wgid = (int)L; { const int q = nwg / 8, r = nwg % 8, xcd = wgid % 8, off = wgid / 8; wgid = (xcd < r ? xcd * (q + 1) : r * (q + 1) + (xcd - r) * q) + off; }
    const int nig = 8 * nN, gid = wgid / nig, fm = gid * 8, gsz = (nM - fm) < 8 ? (nM - fm) : 8;
    pm = fm + ((wgid % nig) % gsz); pn = (wgid % nig) / gsz; return true;
}

DEVI void tile_of(int wgid, int nM, int nN, int& pm, int& pn) {
    const int nwg = nM * nN;
    { const int q = nwg / 8, r = nwg % 8, xcd = wgid % 8, off = wgid / 8; wgid = (xcd < r ? xcd * (q + 1) : r * (q + 1) + (xcd - r) * q) + off; }
    const int nig = 8 * nN, gid = wgid / nig, fm = gid * 8, gsz = (nM - fm) < 8 ? (nM - fm) : 8;
    pm = fm + ((wgid % nig) % gsz); pn = (wgid % nig) / gsz;
}
DEVI bool next_unit_split(int i, int nM, int nN, int nt, int& pm, int& pn, int& k0, int& nk, int& role) {
    const int nwg = nM * nN, G = (int)gridDim.x, full = (nwg / G) * G;
    const long L = (long)i * G + blockIdx.x;
    if (L < full) { tile_of((int)L, nM, nN, pm, pn); k0 = 0; nk = nt; role = 0; return true; }
    if (L >= full + G || nwg - full != G / 2) return false;
    const int r = (int)(L - full), half = G / 2;
    tile_of(full + (r % half), nM, nN, pm, pn);
    role = r < half ? 1 : 2; nk = nt / 2; k0 = role == 2 ? nt / 2 : 0;
    return true;
}
#define XB_TMO      128
#define XB_SPIN_CAP (1u << 18)
DEVI unsigned xb_ld(unsigned* p) { return __hip_atomic_load(p, __ATOMIC_RELAXED, __HIP_MEMORY_SCOPE_AGENT); }
DEVI unsigned xb_add(unsigned* p, unsigned v) { return __hip_atomic_fetch_add(p, v, __ATOMIC_RELAXED, __HIP_MEMORY_SCOPE_AGENT); }
#define XB_SPIN(cond, bar) do { unsigned _sp = 0; while (cond) { __builtin_amdgcn_s_sleep(1); \
    if ((++_sp & 255u) == 0u) { if (xb_ld(&(bar)[XB_TMO])) break; if (_sp > XB_SPIN_CAP) { atomicAdd(&(bar)[XB_TMO], 1u); break; } } } } while (0)

typedef f32x4 acc_t[2][2][4][2];
#define LAS __attribute__((address_space(3)))

#ifndef GEMM_SP2
#define GEMM_SP2 true
#endif
#ifndef GEMM_ALIGN
#define GEMM_ALIGN true
#endif
template <bool SPLIT = false, class Epi>
DEVI void gemm_phase(const bf16_t* __restrict__ A, const bf16_t* __restrict__ Bt, const int M, const int N, const int K, const Epi& E, const int ulimit = 0x7fffffff,
                     float* slab = nullptr, unsigned* flags = nullptr, unsigned* ctl = nullptr) {
    extern __shared__ __attribute__((aligned(16))) unsigned char shm[];
    LAS unsigned char* lds = (LAS unsigned char*)shm;
    constexpr int BK = 64, HALF = 128, HTB = HALF * BK * 2;
    const int tid = phase_tid(), wid = __builtin_amdgcn_readfirstlane(tid >> 6), lane = tid & 63, wr = wid >> 2, wc = wid & 3, fr = lane & 15, fq = lane >> 4;
    const int nt = K / BK, nM = M / 256, nN = N / 256;
    unsigned voff[2];
#pragma unroll
    for (int i = 0; i < 2; ++i) { int R, C; stage_rc(tid * 16 + i * 8192, R, C); voff[i] = (unsigned)(R * K + C) * 2u; }
    const size_t kstep = (size_t)(BK * 2);
    const size_t hstep = (size_t)HALF * K * 2;
    const size_t tstep = 2 * hstep;
    const unsigned ldsw = (unsigned)wid * 1024u;
    const int aoff = lds_byte(wr * 64 + fr, fq * 8), boff = lds_byte(wc * 32 + fr, fq * 8);
#define PG8_SA(b, h) (((b) * 2 + (h)) * HTB)
#define PG8_SB(b, h) ((4 + (b) * 2 + (h)) * HTB)
#define PG8_STAGE(bufoff, gbase) do { _Pragma("unroll") for (int _i = 0; _i < 2; ++_i) \
        __builtin_amdgcn_global_load_lds((const unsigned*)((const char*)(gbase) + voff[_i]), (LAS unsigned*)(lds + (bufoff) + ldsw + _i * 8192), 16, 0, 0); } while (0)
#define PG8_LDA(dst, b, h) do { _Pragma("unroll") for (int m = 0; m < 4; ++m) _Pragma("unroll") for (int k = 0; k < 2; ++k) dst[m][k] = *(const LAS bf16x8*)(lds + PG8_SA(b, h) + aoff + m * 2048 + k * 1024); } while (0)
#define PG8_LDB(dst, b, h) do { _Pragma("unroll") for (int n = 0; n < 2; ++n) _Pragma("unroll") for (int k = 0; k < 2; ++k) dst[n][k] = *(const LAS bf16x8*)(lds + PG8_SB(b, h) + boff + n * 2048 + k * 1024); } while (0)
#define PG8_MMA(ai, bj, At_, Bt_) do { __builtin_amdgcn_s_setprio(1); _Pragma("unroll") for (int m = 0; m < 4; ++m) _Pragma("unroll") for (int n = 0; n < 2; ++n) _Pragma("unroll") for (int k = 0; k < 2; ++k) \
        acc[ai][bj][m][n] = __builtin_amdgcn_mfma_f32_16x16x32_bf16(Bt_[n][k], At_[m][k], acc[ai][bj][m][n], 0, 0, 0); __builtin_amdgcn_s_setprio(0); } while (0)
#define PG8_WAIT_V(n) asm volatile("s_waitcnt vmcnt(" #n ")" ::: "memory")
#define PG8_WAIT_L(n) asm volatile("s_waitcnt lgkmcnt(" #n ")" ::: "memory")
#define PG8_BAR __builtin_amdgcn_s_barrier()
#define PG8_SCHED __builtin_amdgcn_sched_barrier(0)
    int cpm, cpn, npm = 0, npn = 0, ui = 0;
    int ck0 = 0, cnk = nt, crole = 0, nk0 = 0, nnk = nt, nrole = 0;
    if constexpr (SPLIT) { if (!next_unit_split(0, nM, nN, nt, cpm, cpn, ck0, cnk, crole)) return; }
    else { if (!next_unit(0, nM, nN, cpm, cpn, ulimit)) return; }
    acc_t acc;
#pragma unroll
    for (int a = 0; a < 2; ++a)
#pragma unroll
        for (int b = 0; b < 2; ++b)
#pragma unroll
            for (int m = 0; m < 4; ++m)
#pragma unroll
                for (int n = 0; n < 2; ++n) acc[a][b][m][n] = (f32x4){0.f, 0.f, 0.f, 0.f};
    bf16x8 At[4][2], B0[2][2], B1[2][2];
    const char* cA = (const char*)A + (size_t)cpm * tstep + (size_t)ck0 * kstep; const char* cB = (const char*)Bt + (size_t)cpn * tstep + (size_t)ck0 * kstep;
    constexpr bool SP2 = GEMM_SP2, ALIGN_EPI = GEMM_ALIGN && !Epi::AFTER_DRAIN;
    if constexpr (SP2) {
        PG8_STAGE(PG8_SB(0, 0), cB); PG8_STAGE(PG8_SB(0, 1), cB + hstep); PG8_STAGE(PG8_SA(0, 0), cA); PG8_STAGE(PG8_SA(0, 1), cA + hstep);
        if (wr == 1) PG8_BAR;
        PG8_WAIT_V(2); PG8_BAR;
        PG8_STAGE(PG8_SB(1, 0), cB + kstep); PG8_STAGE(PG8_SA(1, 0), cA + kstep); PG8_STAGE(PG8_SB(1, 1), cB + hstep + kstep);
        PG8_WAIT_V(6); PG8_BAR;
    } else {
        PG8_STAGE(PG8_SB(0, 0), cB); PG8_STAGE(PG8_SA(0, 0), cA); PG8_STAGE(PG8_SB(0, 1), cB + hstep); PG8_STAGE(PG8_SA(0, 1), cA + hstep);
        if (wr == 1) PG8_BAR;
        PG8_WAIT_V(4); PG8_BAR;
        PG8_STAGE(PG8_SB(1, 0), cB + kstep); PG8_STAGE(PG8_SA(1, 0), cA + kstep); PG8_STAGE(PG8_SB(1, 1), cB + hstep + kstep);
        PG8_WAIT_V(6); PG8_BAR;
    }
    for (;;) {
        bool has_next;
        if constexpr (SPLIT) has_next = next_unit_split(ui + 1, nM, nN, nt, npm, npn, nk0, nnk, nrole);
        else has_next = next_unit(ui + 1, nM, nN, npm, npn, ulimit);
        const char* nA = has_next ? (const char*)A + (size_t)npm * tstep + (size_t)nk0 * kstep : cA; const char* nB = has_next ? (const char*)Bt + (size_t)npn * tstep + (size_t)nk0 * kstep : cB;
        for (int t = 0; t < cnk; t += 2) {
            const bool last = (t == cnk - 2);
            const char* a1 = cA + (size_t)(t + 1) * kstep;
            const char* a2 = last ? nA : cA + (size_t)(t + 2) * kstep; const char* b2 = last ? nB : cB + (size_t)(t + 2) * kstep;
            const char* a3 = a2 + kstep; const char* b3 = b2 + kstep;
            if constexpr (SP2) {
            PG8_LDB(B0, 0, 0); PG8_LDB(B1, 0, 1); PG8_SCHED; PG8_LDA(At, 0, 0); PG8_STAGE(PG8_SA(1, 1), a1 + hstep);
            PG8_WAIT_V(8); PG8_WAIT_L(0); PG8_BAR; PG8_MMA(0, 0, At, B0); PG8_MMA(0, 1, At, B1); PG8_BAR; PG8_SCHED;
            PG8_LDA(At, 0, 1); PG8_STAGE(PG8_SB(0, 0), b2); PG8_STAGE(PG8_SB(0, 1), b2 + hstep); PG8_STAGE(PG8_SA(0, 0), a2);
            PG8_WAIT_V(8); PG8_WAIT_L(0); PG8_BAR; PG8_MMA(1, 0, At, B0); PG8_MMA(1, 1, At, B1); PG8_BAR; PG8_SCHED;
            PG8_LDB(B0, 1, 0); PG8_LDB(B1, 1, 1); PG8_SCHED; PG8_LDA(At, 1, 0); PG8_STAGE(PG8_SA(0, 1), a2 + hstep);
            PG8_WAIT_V(8); PG8_WAIT_L(0); PG8_BAR; PG8_MMA(0, 0, At, B0); PG8_MMA(0, 1, At, B1); PG8_BAR; PG8_SCHED;
            PG8_LDA(At, 1, 1); PG8_STAGE(PG8_SB(1, 0), b3); PG8_STAGE(PG8_SB(1, 1), b3 + hstep); PG8_STAGE(PG8_SA(1, 0), a3);
            PG8_WAIT_V(8); PG8_WAIT_L(0); PG8_BAR; PG8_MMA(1, 0, At, B0); PG8_MMA(1, 1, At, B1); PG8_BAR; PG8_SCHED;
            } else {
            PG8_LDB(B0, 0, 0); PG8_SCHED; PG8_LDA(At, 0, 0); PG8_STAGE(PG8_SA(1, 1), a1 + hstep);
            PG8_WAIT_L(8); PG8_BAR; PG8_WAIT_L(0); PG8_MMA(0, 0, At, B0); PG8_BAR; PG8_SCHED;
            PG8_LDB(B1, 0, 1); PG8_STAGE(PG8_SB(0, 0), b2);
            PG8_BAR; PG8_WAIT_L(0); PG8_MMA(0, 1, At, B1); PG8_BAR;
            PG8_LDA(At, 0, 1); PG8_STAGE(PG8_SA(0, 0), a2);
            PG8_BAR; PG8_WAIT_L(0); PG8_MMA(1, 0, At, B0); PG8_BAR; PG8_SCHED;
            PG8_STAGE(PG8_SB(0, 1), b2 + hstep);
            PG8_WAIT_V(6); PG8_BAR; PG8_MMA(1, 1, At, B1); PG8_BAR;
            PG8_LDB(B0, 1, 0); PG8_SCHED; PG8_LDA(At, 1, 0); PG8_STAGE(PG8_SA(0, 1), a2 + hstep);
            PG8_WAIT_L(8); PG8_BAR; PG8_WAIT_L(0); PG8_MMA(0, 0, At, B0); PG8_BAR; PG8_SCHED;
            PG8_LDB(B1, 1, 1); PG8_STAGE(PG8_SB(1, 0), b3);
            PG8_BAR; PG8_WAIT_L(0); PG8_MMA(0, 1, At, B1); PG8_BAR;
            PG8_LDA(At, 1, 1); PG8_STAGE(PG8_SA(1, 0), a3);
            PG8_BAR; PG8_WAIT_L(0); PG8_MMA(1, 0, At, B0); PG8_BAR; PG8_SCHED;
            PG8_STAGE(PG8_SB(1, 1), b3 + hstep);
            PG8_WAIT_V(6); PG8_BAR; PG8_MMA(1, 1, At, B1); PG8_BAR;
            }
        }
        if constexpr (ALIGN_EPI) { if (wr == 0) PG8_BAR; }
        if constexpr (!Epi::AFTER_DRAIN) { if (!SPLIT || crole == 0) E(acc, cpm, cpn, wr, wc, fr, fq); }
        if (!has_next) break;
#pragma unroll
        for (int a = 0; a < 2; ++a)
#pragma unroll
            for (int b = 0; b < 2; ++b)
#pragma unroll
                for (int m = 0; m < 4; ++m)
#pragma unroll
                    for (int n = 0; n < 2; ++n) acc[a][b][m][n] = (f32x4){0.f, 0.f, 0.f, 0.f};
        cpm = npm; cpn = npn; cA = nA; cB = nB; ++ui;
        if constexpr (SPLIT) { ck0 = nk0; cnk = nnk; crole = nrole; }
        if constexpr (ALIGN_EPI) { if (wr == 1) PG8_BAR; }
    }
    PG8_WAIT_V(0);
    if constexpr (!ALIGN_EPI) { if (wr == 0) PG8_BAR; }
    PG8_BAR;
    if constexpr (Epi::AFTER_DRAIN) E.fused(acc, cpm, cpn, wr, wc, fr, fq);
    if constexpr (SPLIT) {
        if (crole != 0) {
            const int pair = (int)blockIdx.x & ((int)gridDim.x / 2 - 1);
            float* sl = slab + (size_t)pair * 65536 + (size_t)tid * 4;
            if (crole == 2) {
#pragma unroll
                for (int a = 0; a < 2; ++a)
#pragma unroll
                    for (int b = 0; b < 2; ++b)
#pragma unroll
                        for (int m = 0; m < 4; ++m)
#pragma unroll
                            for (int n = 0; n < 2; ++n) {
                                float* ptr = sl + (size_t)(((a * 2 + b) * 4 + m) * 2 + n) * 2048;
                                asm volatile("global_store_dwordx4 %0, %1, off sc0 sc1\n\ts_nop 2" :: "v"(ptr), "v"(acc[a][b][m][n]) : "memory");
                            }
                asm volatile("s_waitcnt vmcnt(0)" ::: "memory");
                __syncthreads();
                if (threadIdx.x == 0) __hip_atomic_store(flags + pair * 16, 1u, __ATOMIC_RELAXED, __HIP_MEMORY_SCOPE_AGENT);
            } else {
                if (threadIdx.x == 0) { XB_SPIN(xb_ld(flags + pair * 16) == 0u, ctl); __builtin_amdgcn_fence(__ATOMIC_ACQUIRE, "agent"); asm volatile("s_waitcnt vmcnt(0)" ::: "memory"); }
                __syncthreads();
                E.with_partial(acc, sl, cpm, cpn, wr, wc, fr, fq);
            }
        }
    }
#undef PG8_SA
#undef PG8_SB
#undef PG8_STAGE
#undef PG8_LDA
#undef PG8_LDB
#undef PG8_MMA
}

struct EpiNull {
    static constexpr bool AFTER_DRAIN = false;
    float* sink;
    DEVI void operator()(const acc_t& acc, int pm, int pn, int wr, int wc, int fr, int fq) const {
        if (pm < 0) {
#pragma unroll
            for (int ai = 0; ai < 2; ++ai)
#pragma unroll
                for (int bj = 0; bj < 2; ++bj)
#pragma unroll
                    for (int m = 0; m < 4; ++m) { *(f32x4*)(sink + fr * 8) = acc[ai][bj][m][0]; *(f32x4*)(sink + fq * 8 + 4) = acc[ai][bj][m][1]; }
        }
    }
};
struct EpiSwiglu {
    static constexpr bool AFTER_DRAIN = false;
    bf16_t* U;
    template <bool PART>
    DEVI void run(const acc_t& acc, const float* sl, int pm, int pn, int wr, int wc, int fr, int fq) const {
        f32x4 pc[4] = {}, pnx[4] = {};
#define PLOAD(dst, it_) do { const int ai_ = (it_) >> 2, m_ = (it_) & 3; \
        dst[0] = *(const f32x4*)(sl + (size_t)(((ai_ * 2 + 0) * 4 + m_) * 2 + 0) * 2048); dst[1] = *(const f32x4*)(sl + (size_t)(((ai_ * 2 + 0) * 4 + m_) * 2 + 1) * 2048); \
        dst[2] = *(const f32x4*)(sl + (size_t)(((ai_ * 2 + 1) * 4 + m_) * 2 + 0) * 2048); dst[3] = *(const f32x4*)(sl + (size_t)(((ai_ * 2 + 1) * 4 + m_) * 2 + 1) * 2048); } while (0)
        if (PART) PLOAD(pc, 0);
#pragma unroll
        for (int it = 0; it < 8; ++it) {
            const int ai = it >> 2, m = it & 3;
            const int row = pm * 256 + ai * 128 + wr * 64 + m * 16 + fr;
            if (PART && it < 7) PLOAD(pnx, it + 1);
            f32x4 g0 = acc[ai][0][m][0], g1 = acc[ai][0][m][1], u0 = acc[ai][1][m][0], u1 = acc[ai][1][m][1];
            if (PART) { g0 += pc[0]; g1 += pc[1]; u0 += pc[2]; u1 += pc[3]; }
            u32x4 w;
            w.x = cvt_pk_bf16(silu_f(g0[0]) * u0[0], silu_f(g0[1]) * u0[1]);
            w.y = cvt_pk_bf16(silu_f(g0[2]) * u0[2], silu_f(g0[3]) * u0[3]);
            w.z = cvt_pk_bf16(silu_f(g1[0]) * u1[0], silu_f(g1[1]) * u1[1]);
            w.w = cvt_pk_bf16(silu_f(g1[2]) * u1[2], silu_f(g1[3]) * u1[3]);
            *(u32x4*)(U + (size_t)row * DFF + pn * 128 + wc * 32 + 8 * fq) = w;
            if (PART) { pc[0] = pnx[0]; pc[1] = pnx[1]; pc[2] = pnx[2]; pc[3] = pnx[3]; }
        }
#undef PLOAD
    }
    DEVI void operator()(const acc_t& acc, int pm, int pn, int wr, int wc, int fr, int fq) const { run<false>(acc, nullptr, pm, pn, wr, wc, fr, fq); }
    DEVI void with_partial(const acc_t& acc, const float* sl, int pm, int pn, int wr, int wc, int fr, int fq) const { run<true>(acc, sl, pm, pn, wr, wc, fr, fq); }
};
DEVI u32x4 pack8(const f32x4 a, const f32x4 b, float s) {
    u32x4 w; w.x = cvt_pk_bf16(a[0] * s, a[1] * s); w.y = cvt_pk_bf16(a[2] * s, a[3] * s); w.z = cvt_pk_bf16(b[0] * s, b[1] * s); w.w = cvt_pk_bf16(b[2] * s, b[3] * s); return w;
}
DEVI float sq8(const f32x4 a, const f32x4 b) { return a[0] * a[0] + a[1] * a[1] + a[2] * a[2] + a[3] * a[3] + b[0] * b[0] + b[1] * b[1] + b[2] * b[2] + b[3] * b[3]; }
struct EpiY {
    static constexpr bool AFTER_DRAIN = false;
    bf16_t* Y; int ldy; float* ss;
    DEVI void operator()(const acc_t& acc, int pm, int pn, int wr, int wc, int fr, int fq) const {
#pragma unroll
        for (int ai = 0; ai < 2; ++ai)
#pragma unroll
            for (int m = 0; m < 4; ++m) {
                const int row = pm * 256 + ai * 128 + wr * 64 + m * 16 + fr;
                float s = 0.f;
#pragma unroll
                for (int bj = 0; bj < 2; ++bj) {
                    s += sq8(acc[ai][bj][m][0], acc[ai][bj][m][1]);
                    *(u32x4*)(Y + (size_t)row * ldy + pn * 256 + bj * 128 + wc * 32 + 8 * fq) = pack8(acc[ai][bj][m][0], acc[ai][bj][m][1], 1.0f);
                }
                s += __shfl_xor(s, 16); s += __shfl_xor(s, 32);
                if (fq == 0) unsafeAtomicAdd(ss + row, s);
            }
    }
};
DEVI void store_vt_tile(bf16_t* __restrict__ Vt, const acc_t& acc, int ai, int bj, int head, int rowblk  , int wr, int wc, int fr, int fq, const float (&sc)[4]) {
    extern __shared__ __attribute__((aligned(16))) unsigned char shm[];
    LAS unsigned char* wl = (LAS unsigned char*)shm + LDS_VT + (wr * 4 + wc) * 2560;
    const int lane = fq * 16 + fr;
#pragma unroll
    for (int mh = 0; mh < 2; ++mh) {
        asm volatile("" ::: "memory");
#pragma unroll
        for (int mm = 0; mm < 2; ++mm) {
            const int m = 2 * mh + mm, tl = mm * 16 + fr;
            const u32x4 w = pack8(acc[ai][bj][m][0], acc[ai][bj][m][1], sc[m]);
            LAS unsigned short* p = (LAS unsigned short*)(wl + (8 * fq) * 80 + tl * 2);
            p[0 * 40] = (unsigned short)(w.x & 0xffff); p[1 * 40] = (unsigned short)(w.x >> 16);
            p[2 * 40] = (unsigned short)(w.y & 0xffff); p[3 * 40] = (unsigned short)(w.y >> 16);
            p[4 * 40] = (unsigned short)(w.z & 0xffff); p[5 * 40] = (unsigned short)(w.z >> 16);
            p[6 * 40] = (unsigned short)(w.w & 0xffff); p[7 * 40] = (unsigned short)(w.w >> 16);
        }
        asm volatile("s_waitcnt lgkmcnt(0)" ::: "memory");
        const int tok = rowblk + mh * 32, bb = tok >> 12, sp = tok & 4095;
#pragma unroll
        for (int k = 0; k < 2; ++k) {
            const int c = lane + 64 * k, dr = c >> 2, part = c & 3;
            const u32x4 v = *(const LAS u32x4*)(wl + dr * 80 + part * 16);
            *(u32x4*)(Vt + ((size_t)(bb * 8 + head) * 128 + wc * 32 + dr) * SEQ + sp + part * 8) = v;
        }
        asm volatile("s_waitcnt lgkmcnt(0)" ::: "memory");
    }
}
DEVI float log_sigmoid_f(float x) { const float e = __expf(-fabsf(x)); return fminf(x, 0.f) - __logf(1.0f + e); }
struct EpiIn {
    static constexpr bool AFTER_DRAIN = false;
    bf16_t *QA, *KVA, *KR, *FQ, *FK, *VTF; float *ssq, *sskv, *logf; const float *ropec, *ropes, *b_forget;
    DEVI void operator()(const acc_t& acc, int pm, int pn, int wr, int wc, int fr, int fq) const {
        const float qs = LOG2E * 0.08838834764831845f;
        if (pn >= 12) {
            const float one[4] = {1.0f, 1.0f, 1.0f, 1.0f};
#pragma unroll
            for (int ai = 0; ai < 2; ++ai)
#pragma unroll
                for (int bj = 0; bj < 2; ++bj) store_vt_tile(VTF, acc, ai, bj, 2 * (pn - 12) + bj, pm * 256 + ai * 128 + wr * 64, wr, wc, fr, fq, one);
            return;
        }
        if (pn == 3) {
            const int row0 = pm * 256 + wr * 64 + fr;
            if (wc == 0) {
                f32x4 tc[4], tn[4];
#define TLOAD(dst, it_) do { const int pos_ = (row0 + ((it_) >> 2) * 128 + ((it_) & 3) * 16) & 4095; \
                dst[0] = *(const f32x4*)(ropec + pos_ * 32 + 8 * fq); dst[1] = *(const f32x4*)(ropes + pos_ * 32 + 8 * fq); \
                dst[2] = *(const f32x4*)(ropec + pos_ * 32 + 8 * fq + 4); dst[3] = *(const f32x4*)(ropes + pos_ * 32 + 8 * fq + 4); } while (0)
                TLOAD(tc, 0);
#pragma unroll
                for (int it = 0; it < 8; ++it) {
                    const int ai = it >> 2, m = it & 3, row = row0 + ai * 128 + m * 16;
                    if (it < 7) TLOAD(tn, it + 1);
#pragma unroll
                    for (int n = 0; n < 2; ++n) {
                        const int i0 = 8 * fq + 4 * n;
                        const f32x4 cs = tc[2 * n], sn = tc[2 * n + 1];
                        const f32x4 x1 = acc[ai][0][m][n], x2 = acc[ai][1][m][n];
                        const f32x4 o1 = x1 * cs - x2 * sn, o2 = x1 * sn + x2 * cs;
                        u32x2 w1, w2; w1.x = cvt_pk_bf16(o1[0], o1[1]); w1.y = cvt_pk_bf16(o1[2], o1[3]); w2.x = cvt_pk_bf16(o2[0], o2[1]); w2.y = cvt_pk_bf16(o2[2], o2[3]);
                        *(u32x2*)(KR + (size_t)row * 64 + i0) = w1;
                        *(u32x2*)(KR + (size_t)row * 64 + 32 + i0) = w2;
                    }
#pragma unroll
                    for (int k = 0; k < 4; ++k) tc[k] = tn[k];
                }
#undef TLOAD
            } else if (wc == 1 && fq == 0) {
                f32x4 bf0 = *(const f32x4*)(b_forget), bf1 = *(const f32x4*)(b_forget + 4);
#pragma unroll
                for (int it = 0; it < 8; ++it) {
                    const int ai = it >> 2, m = it & 3, row = row0 + ai * 128 + m * 16;
                    f32x4 l0, l1;
#pragma unroll
                    for (int j = 0; j < 4; ++j) { l0[j] = log_sigmoid_f(acc[ai][0][m][0][j] + bf0[j]); l1[j] = log_sigmoid_f(acc[ai][0][m][1][j] + bf1[j]); }
                    *(f32x4*)(logf + (size_t)row * 8) = l0; *(f32x4*)(logf + (size_t)row * 8 + 4) = l1;
                }
            }
            return;
        }
#pragma unroll
        for (int ai = 0; ai < 2; ++ai)
#pragma unroll
            for (int m = 0; m < 4; ++m) {
                const int row = pm * 256 + ai * 128 + wr * 64 + m * 16 + fr;
                if (pn < 3) {
                    bf16_t* dst = pn < 2 ? QA + (size_t)row * 512 + pn * 256 : KVA + (size_t)row * 256;
                    float s = 0.f;
#pragma unroll
                    for (int bj = 0; bj < 2; ++bj) {
                        s += sq8(acc[ai][bj][m][0], acc[ai][bj][m][1]);
                        *(u32x4*)(dst + bj * 128 + wc * 32 + 8 * fq) = pack8(acc[ai][bj][m][0], acc[ai][bj][m][1], 1.0f);
                    }
                    s += __shfl_xor(s, 16); s += __shfl_xor(s, 32);
                    if (fq == 0) unsafeAtomicAdd((pn < 2 ? ssq : sskv) + row, s);
                } else {
                    bf16_t* dst = (pn < 8 ? FQ : FK) + (size_t)row * 1024 + ((pn - 4) & 3) * 256;
                    const float sc = pn < 8 ? qs : 1.0f;
#pragma unroll
                    for (int bj = 0; bj < 2; ++bj) *(u32x4*)(dst + bj * 128 + wc * 32 + 8 * fq) = pack8(acc[ai][bj][m][0], acc[ai][bj][m][1], sc);
                }
            }
    }
};
struct EpiQ {
    static constexpr bool AFTER_DRAIN = false;
    bf16_t* QM; const float *ssq, *ropec, *ropes;
    DEVI void operator()(const acc_t& acc, int pm, int pn, int wr, int wc, int fr, int fq) const {
        const float qs = LOG2E * 0.07216878364870323f;
        const int row0 = pm * 256 + wr * 64 + fr;
        float rs[8];
#pragma unroll
        for (int it = 0; it < 8; ++it) rs[it] = ssq[row0 + (it >> 2) * 128 + (it & 3) * 16];
#pragma unroll
        for (int it = 0; it < 8; ++it) rs[it] = rsqrtf(rs[it] * (1.0f / 512.0f) + EPS) * qs;
        if (pn < 4) {
#pragma unroll
            for (int it = 0; it < 8; ++it) {
                const int ai = it >> 2, m = it & 3, row = row0 + ai * 128 + m * 16;
#pragma unroll
                for (int bj = 0; bj < 2; ++bj)
                    *(u32x4*)(QM + (size_t)row * 1536 + (2 * pn + bj) * 192 + wc * 32 + 8 * fq) = pack8(acc[ai][bj][m][0], acc[ai][bj][m][1], rs[it]);
            }
        } else {
            const int head = 4 * (pn - 4) + wc;
            f32x4 tc[4], tn[4];
#define TLOAD(dst, it_) do { const int pos_ = (row0 + ((it_) >> 2) * 128 + ((it_) & 3) * 16) & 4095; \
            dst[0] = *(const f32x4*)(ropec + pos_ * 32 + 8 * fq); dst[1] = *(const f32x4*)(ropes + pos_ * 32 + 8 * fq); \
            dst[2] = *(const f32x4*)(ropec + pos_ * 32 + 8 * fq + 4); dst[3] = *(const f32x4*)(ropes + pos_ * 32 + 8 * fq + 4); } while (0)
            TLOAD(tc, 0);
#pragma unroll
            for (int it = 0; it < 8; ++it) {
                const int ai = it >> 2, m = it & 3, row = row0 + ai * 128 + m * 16;
                if (it < 7) TLOAD(tn, it + 1);
#pragma unroll
                for (int n = 0; n < 2; ++n) {
                    const int i0 = 8 * fq + 4 * n;
                    const f32x4 cs = tc[2 * n], sn = tc[2 * n + 1];
                    const f32x4 x1 = acc[ai][0][m][n] * rs[it], x2 = acc[ai][1][m][n] * rs[it];
                    const f32x4 o1 = x1 * cs - x2 * sn, o2 = x1 * sn + x2 * cs;
                    u32x2 w1, w2; w1.x = cvt_pk_bf16(o1[0], o1[1]); w1.y = cvt_pk_bf16(o1[2], o1[3]); w2.x = cvt_pk_bf16(o2[0], o2[1]); w2.y = cvt_pk_bf16(o2[2], o2[3]);
                    *(u32x2*)(QM + (size_t)row * 1536 + head * 192 + 128 + i0) = w1;
                    *(u32x2*)(QM + (size_t)row * 1536 + head * 192 + 160 + i0) = w2;
                }
#pragma unroll
                for (int k = 0; k < 4; ++k) tc[k] = tn[k];
            }
#undef TLOAD
        }
    }
};
struct EpiKV {
    static constexpr bool AFTER_DRAIN = false;
    bf16_t *KN, *VTM; const float* sskv;
    DEVI void operator()(const acc_t& acc, int pm, int pn, int wr, int wc, int fr, int fq) const {
#pragma unroll
        for (int ai = 0; ai < 2; ++ai) {
            float rs[4];
#pragma unroll
            for (int m = 0; m < 4; ++m) rs[m] = rsqrtf(sskv[pm * 256 + ai * 128 + wr * 64 + m * 16 + fr] * (1.0f / 256.0f) + EPS);
            if (pn < 4) {
#pragma unroll
                for (int m = 0; m < 4; ++m) {
                    const int row = pm * 256 + ai * 128 + wr * 64 + m * 16 + fr;
#pragma unroll
                    for (int bj = 0; bj < 2; ++bj)
                        *(u32x4*)(KN + (size_t)row * 1024 + pn * 256 + bj * 128 + wc * 32 + 8 * fq) = pack8(acc[ai][bj][m][0], acc[ai][bj][m][1], rs[m]);
                }
            } else {
#pragma unroll
                for (int bj = 0; bj < 2; ++bj) store_vt_tile(VTM, acc, ai, bj, 2 * (pn - 4) + bj, pm * 256 + ai * 128 + wr * 64, wr, wc, fr, fq, rs);
            }
        }
    }
};

DEVI void cumsum_unit(const float* __restrict__ logf, float* __restrict__ cum, int bh) {
    const int lane = phase_tid() & 63, b = bh >> 3, h = bh & 7;
    const float* src = logf + ((size_t)b * SEQ + lane * 64) * 8 + h;
    float s = 0.f;
    for (int i = 0; i < 64; ++i) s += src[i * 8];
    float incl = s;
#pragma unroll
    for (int o = 1; o < 64; o <<= 1) { const float t = __shfl_up(incl, o); if (lane >= o) incl += t; }
    float run = incl - s;
    float* dst = cum + (size_t)bh * SEQ + lane * 64;
    for (int i = 0; i < 64; ++i) { run += src[i * 8]; dst[i] = -run * LOG2E; }
}

template <int DQK, bool FOX>
DEVI void attn_item(const bf16_t* __restrict__ Q, int ldq, const bf16_t* __restrict__ K1, const bf16_t* __restrict__ K2, const bf16_t* __restrict__ Vt,
                    const float* __restrict__ cum, bf16_t* __restrict__ O, int qb) {
    extern __shared__ __attribute__((aligned(16))) unsigned char shm[];
    constexpr int KSTR = DQK * 2 + 16, VSTR = 144, CPR = DQK / 8, NKC = 64 * CPR / 512, KBUF = 64 * KSTR, VBUF = 128 * VSTR, NKS = DQK / 16;
    unsigned char* Kb = shm; unsigned char* Vb = shm + 2 * KBUF; float* Cb = (float*)(shm + 2 * KBUF + 2 * VBUF);
    const int tid = phase_tid(), wid = tid >> 6, lane = tid & 63, n = lane & 31, g = lane >> 5;
    const int Q0 = qb * 256, q0w = Q0 + wid * 32;
    const int ntile = Q0 / 64 + 4, mytiles = q0w / 64 + 1;
    const int pin = (n & 0x13) | ((n & 4) << 1) | ((n & 8) >> 1);

    bf16x8 qf[NKS];
#pragma unroll
    for (int ks = 0; ks < NKS; ++ks) qf[ks] = *(const bf16x8*)(Q + (size_t)(q0w + n) * ldq + ks * 16 + g * 8);
    f32x16 o[4];
#pragma unroll
    for (int mt = 0; mt < 4; ++mt)
#pragma unroll
        for (int i = 0; i < 16; ++i) o[mt][i] = 0.f;
    float mrun = -INFINITY, lrun = 0.f;

    u32x4 kreg[NKC], vreg[2]; float creg = 0.f;
    int kgo[2], klo[2], vgo[2], vlo[2];
#pragma unroll
    for (int i_ = 0; i_ < 2; ++i_) {
        const int c_ = tid + i_ * 512;
        kgo[i_] = (c_ >> 4) * 1024 + (c_ & 15) * 8; klo[i_] = (c_ >> 4) * KSTR + (c_ & 15) * 16;
        vgo[i_] = (c_ >> 3) * SEQ + (c_ & 7) * 8;    vlo[i_] = (c_ >> 3) * VSTR + (c_ & 7) * 16;
    }
    const int rgo = (tid >> 3) * 64 + (tid & 7) * 8, rlo = (tid >> 3) * KSTR + 256 + (tid & 7) * 16;
#define GLOAD(kt_) do { const int k0_ = (kt_) * 64; \
    const bf16_t* kb_ = K1 + (size_t)k0_ * 1024; const bf16_t* vb_ = Vt + k0_; \
    _Pragma("unroll") for (int i_ = 0; i_ < 2; ++i_) { kreg[i_] = *(const u32x4*)(kb_ + kgo[i_]); vreg[i_] = *(const u32x4*)(vb_ + vgo[i_]); } \
    if (!FOX) { const bf16_t* rb_ = K2 + (size_t)k0_ * 64; kreg[NKC - 1] = *(const u32x4*)(rb_ + rgo); } \
    if (FOX && tid < 64) creg = cum[k0_ + tid]; } while (0)
#define LSTORE(buf_) do { \
    _Pragma("unroll") for (int i_ = 0; i_ < 2; ++i_) { *(u32x4*)(Kb + (buf_) * KBUF + klo[i_]) = kreg[i_]; *(u32x4*)(Vb + (buf_) * VBUF + vlo[i_]) = vreg[i_]; } \
    if (!FOX) *(u32x4*)(Kb + (buf_) * KBUF + rlo) = kreg[NKC - 1]; \
    if (FOX && tid < 64) Cb[(buf_) * 64 + tid] = creg; } while (0)

#define TILE_OF(j_) (FOX ? (ntile - 1 - (j_)) : (j_))
    __syncthreads();
    GLOAD(TILE_OF(0)); LSTORE(0); GLOAD(TILE_OF(1));
    __syncthreads();
    for (int j = 0; j < ntile; ++j) {
        const int buf = j & 1, kt = TILE_OF(j);
        if (j + 1 < ntile) LSTORE(buf ^ 1);
        if (j + 2 < ntile) GLOAD(TILE_OF(j + 2));
        if (kt < mytiles) {
            f32x16 st[2];
            if (FOX) {
#pragma unroll
                for (int sub = 0; sub < 2; ++sub)
#pragma unroll
                    for (int half = 0; half < 2; ++half) {
                        const int kofs = sub * 32 + half * 16 + 8 * g;
                        const f32x4 c0 = *(const f32x4*)(Cb + buf * 64 + kofs), c1 = *(const f32x4*)(Cb + buf * 64 + kofs + 4);
#pragma unroll
                        for (int jj = 0; jj < 4; ++jj) { st[sub][half * 8 + jj] = c0[jj]; st[sub][half * 8 + 4 + jj] = c1[jj]; }
                    }
                if (kt == mytiles - 1) {
                    const int tq = q0w + n;
#pragma unroll
                    for (int sub = 0; sub < 2; ++sub)
#pragma unroll
                        for (int i = 0; i < 16; ++i) { const int key = kt * 64 + sub * 32 + (i >> 3) * 16 + 8 * g + (i & 7); if (key > tq) st[sub][i] = -INFINITY; }
                }
            } else {
#pragma unroll
                for (int sub = 0; sub < 2; ++sub)
#pragma unroll
                    for (int i = 0; i < 16; ++i) st[sub][i] = 0.f;
            }
#pragma unroll
            for (int sub = 0; sub < 2; ++sub) {
                const unsigned char* kb = Kb + buf * KBUF + (sub * 32 + pin) * KSTR + g * 16;
#pragma unroll
                for (int ks = 0; ks < NKS; ++ks) st[sub] = __builtin_amdgcn_mfma_f32_32x32x16_bf16(*(const bf16x8*)(kb + ks * 32), qf[ks], st[sub], 0, 0, 0);
            }
            float mx = st[0][0];
#pragma unroll
            for (int i = 1; i < 16; ++i) mx = fmaxf(mx, st[0][i]);
#pragma unroll
            for (int i = 0; i < 16; ++i) mx = fmaxf(mx, st[1][i]);
            mx = fmaxf(mx, __shfl_xor(mx, 32));
            if (FOX) {
                const float mnew = fmaxf(mrun, mx);
                const float alpha = fast_exp2(mrun - mnew);
                mrun = mnew; lrun *= alpha;
                if (__builtin_amdgcn_ballot_w64(alpha != 1.0f) != 0ull) {
#pragma unroll
                    for (int mt = 0; mt < 4; ++mt)
#pragma unroll
                        for (int i = 0; i < 16; ++i) o[mt][i] *= alpha;
                }
            } else {
                if (__builtin_amdgcn_ballot_w64(!(mx - mrun <= 64.0f)) != 0ull) {
                    const float mnew = fmaxf(mrun, mx);
                    const float alpha = fast_exp2(mrun - mnew);
                    mrun = mnew; lrun *= alpha;
#pragma unroll
                    for (int mt = 0; mt < 4; ++mt)
#pragma unroll
                        for (int i = 0; i < 16; ++i) o[mt][i] *= alpha;
                }
            }
            float psum = 0.f;
#pragma unroll
            for (int sub = 0; sub < 2; ++sub)
#pragma unroll
                for (int i = 0; i < 16; ++i) { const float pv = fast_exp2(st[sub][i] - mrun); st[sub][i] = pv; psum += pv; }
            lrun += psum;
            bf16x8 pf[2][2];
#pragma unroll
            for (int sub = 0; sub < 2; ++sub)
#pragma unroll
                for (int half = 0; half < 2; ++half) {
                    u32x4 w;
                    w.x = cvt_pk_bf16(st[sub][half * 8 + 0], st[sub][half * 8 + 1]); w.y = cvt_pk_bf16(st[sub][half * 8 + 2], st[sub][half * 8 + 3]);
                    w.z = cvt_pk_bf16(st[sub][half * 8 + 4], st[sub][half * 8 + 5]); w.w = cvt_pk_bf16(st[sub][half * 8 + 6], st[sub][half * 8 + 7]);
                    pf[sub][half] = __builtin_bit_cast(bf16x8, w);
                }
#pragma unroll
            for (int mt = 0; mt < 4; ++mt) {
                const unsigned char* vb = Vb + buf * VBUF + (mt * 32 + n) * VSTR + g * 16;
#pragma unroll
                for (int sub = 0; sub < 2; ++sub)
#pragma unroll
                    for (int half = 0; half < 2; ++half)
                        o[mt] = __builtin_amdgcn_mfma_f32_32x32x16_bf16(*(const bf16x8*)(vb + (sub * 32 + half * 16) * 2), pf[sub][half], o[mt], 0, 0, 0);
            }
        }
        asm volatile("s_waitcnt lgkmcnt(0)" ::: "memory");
        __builtin_amdgcn_s_barrier();
        asm volatile("" ::: "memory");
    }
    const float ltot = lrun + __shfl_xor(lrun, 32);
    const float inv = 1.0f / ltot;
    bf16_t* orow = O + (size_t)(q0w + n) * DM;
#pragma unroll
    for (int mt = 0; mt < 4; ++mt)
#pragma unroll
        for (int q4 = 0; q4 < 4; ++q4) {
            u32x2 w; w.x = cvt_pk_bf16(o[mt][4 * q4 + 0] * inv, o[mt][4 * q4 + 1] * inv); w.y = cvt_pk_bf16(o[mt][4 * q4 + 2] * inv, o[mt][4 * q4 + 3] * inv);
            *(u32x2*)(orow + mt * 32 + 8 * q4 + 4 * g) = w;
        }
#undef GLOAD
#undef LSTORE
#undef TILE_OF
}

#define XB_XCNT(j)  (256  + 64 * (j))
#define XB_XSUB(j)  (1280 + 64 * (j))
#define XB_XGEN(j)  (2304 + 64 * (j))
#define XB_TOP      3328
#define XB_TOPGEN   3392
#define XCD_BAR_WORDS 3456
#define CTL_GEMV 3456
#define CTL_QUEUE 3520
DEVI unsigned xb_xcc_id() { return (unsigned)__builtin_amdgcn_s_getreg((3 << 11) | 20) & 0xFu; }
DEVI void xcd_barrier_complete(unsigned* bar, unsigned x, unsigned& nloc, unsigned& nx) {
    const unsigned G = gridDim.x;
    unsigned sum, cnt, mine, sp = 0u;
    for (;;) {
        sum = 0u; cnt = 0u; mine = 0u;
#pragma unroll
        for (unsigned j = 0; j < 16; ++j) { const unsigned c = xb_ld(&bar[XB_XCNT(j)]); sum += c; cnt += (c > 0u) ? 1u : 0u; mine = (j == x) ? c : mine; }
        if (sum == G) break;
        __builtin_amdgcn_s_sleep(1);
        if ((++sp & 255u) == 0u) { if (xb_ld(&bar[XB_TMO])) break; if (sp > XB_SPIN_CAP) { atomicAdd(&bar[XB_TMO], 1u); break; } }
    }
    nloc = mine > 0u ? mine : 1u; nx = cnt > 0u ? cnt : 1u;
}
DEVI void xcd_barrier() {
    extern __shared__ __attribute__((aligned(16))) unsigned char shm[];
    volatile LAS unsigned* st = (volatile LAS unsigned*)((LAS unsigned char*)shm + LDS_MAIN);
    asm volatile("s_waitcnt vmcnt(0)" ::: "memory");
    __syncthreads();
    if (threadIdx.x == 0) {
        KP kq = kparams();
        unsigned* bar = (unsigned*)(kq->ws + WS_BAR);
        const unsigned x = xb_xcc_id();
        __builtin_amdgcn_s_waitcnt(0);
        unsigned nloc = st[0], nx = st[1];
        if (nloc == 0u) { xcd_barrier_complete(bar, x, nloc, nx); st[0] = nloc; st[1] = nx; }
        const unsigned old = xb_add(&bar[XB_XSUB(x)], 1u);
        const unsigned gen = old / nloc;
        if (old + 1u == (gen + 1u) * nloc) {
            __builtin_amdgcn_fence(__ATOMIC_RELEASE, "agent");
            asm volatile("s_waitcnt vmcnt(0)" ::: "memory");
            const unsigned og = xb_add(&bar[XB_TOP], 1u);
            const unsigned tg = og / nx;
            if (og + 1u == (tg + 1u) * nx) xb_add(&bar[XB_TOPGEN], 1u);
            else XB_SPIN(xb_ld(&bar[XB_TOPGEN]) == tg, bar);
            __builtin_amdgcn_fence(__ATOMIC_ACQUIRE, "agent");
            xb_add(&bar[XB_XGEN(x)], 1u);
            asm volatile("s_waitcnt vmcnt(0)" ::: "memory");
        } else {
            XB_SPIN(xb_ld(&bar[XB_XGEN(x)]) == gen, bar);
            __builtin_amdgcn_fence(__ATOMIC_ACQUIRE, "agent");
            asm volatile("s_waitcnt vmcnt(0)" ::: "memory");
        }
    }
    __syncthreads();
}
DEVI void xcd_barrier_post() {
    extern __shared__ __attribute__((aligned(16))) unsigned char shm[];
    volatile LAS unsigned* st = (volatile LAS unsigned*)((LAS unsigned char*)shm + LDS_MAIN);
    if (threadIdx.x < 2) st[threadIdx.x] = 0u;
    __syncthreads();
    if (threadIdx.x == 0) { KP kq = kparams(); unsigned* bar = (unsigned*)(kq->ws + WS_BAR); (void)xb_add(&bar[XB_XCNT(xb_xcc_id())], 1u); }
}

DEVI void panel_wait(unsigned* cnt, unsigned target, unsigned* ctl) {
    asm volatile("s_waitcnt vmcnt(0)" ::: "memory");
    __syncthreads();
    if (threadIdx.x == 0) { (void)xb_add(cnt, 1u); XB_SPIN(xb_ld(cnt) < target, ctl); }
    __syncthreads();
}
DEVI f32x4 bf4_lo(const u32x4 w) { return (f32x4){__uint_as_float(w.x << 16), __uint_as_float(w.x & 0xffff0000u), __uint_as_float(w.y << 16), __uint_as_float(w.y & 0xffff0000u)}; }
DEVI f32x4 bf4_hi(const u32x4 w) { return (f32x4){__uint_as_float(w.z << 16), __uint_as_float(w.z & 0xffff0000u), __uint_as_float(w.w << 16), __uint_as_float(w.w & 0xffff0000u)}; }
#ifndef EPI_NB_BF
#define EPI_NB_BF 4
#endif
#ifndef EPI_NB_F32
#define EPI_NB_F32 2
#endif
template <bool XIN_BF, bool XOUT_BF, bool HAS_H>
struct EpiRes {
    static constexpr bool AFTER_DRAIN = true;
    const void* xin; void* xout; float* ss1; float* ss2; unsigned* cnt; unsigned* ctl;
    const float *gpost, *gate; float coeff; const float *gpre, *shift, *scale; bf16_t* H;
    DEVI void operator()(const acc_t&, int, int, int, int, int, int) const {}
    DEVI void fused(acc_t& acc, int pm, int pn, int wr, int wc, int fr, int fq) const {
        const int row0 = pm * 256 + wr * 64 + fr, col0 = pn * 256 + wc * 32 + 8 * fq;
#pragma unroll
        for (int ai = 0; ai < 2; ++ai)
#pragma unroll
            for (int m = 0; m < 4; ++m) {
                float s = sq8(acc[ai][0][m][0], acc[ai][0][m][1]) + sq8(acc[ai][1][m][0], acc[ai][1][m][1]);
                s += __shfl_xor(s, 16); s += __shfl_xor(s, 32);
                if (fq == 0) unsafeAtomicAdd(ss1 + row0 + ai * 128 + m * 16, s);
            }
        const int bb = (pm * 256) >> 12;
        f32x4 gg[2][2];
#pragma unroll
        for (int bj = 0; bj < 2; ++bj)
#pragma unroll
            for (int hh = 0; hh < 2; ++hh) {
                const int col = col0 + bj * 128 + 4 * hh;
                gg[bj][hh] = *(const f32x4*)(gpost + col) * *(const f32x4*)(gate + (size_t)bb * NMOD + col) * coeff;
            }
        panel_wait(cnt + pm * 64, 8u, ctl);
        float rs1[8];
#pragma unroll
        for (int it = 0; it < 8; ++it) rs1[it] = __hip_atomic_load(ss1 + row0 + (it >> 2) * 128 + (it & 3) * 16, __ATOMIC_RELAXED, __HIP_MEMORY_SCOPE_AGENT);
#pragma unroll
        for (int it = 0; it < 8; ++it) rs1[it] = rsqrtf(rs1[it] * (1.0f / DM) + EPS);
        constexpr int NB = XIN_BF ? EPI_NB_BF : EPI_NB_F32;
#pragma unroll
        for (int it0 = 0; it0 < 8; it0 += NB) {
            u32x4 xr[NB][2][XIN_BF ? 1 : 2];
#pragma unroll
            for (int k = 0; k < NB; ++k) {
                const int row_ = row0 + ((it0 + k) >> 2) * 128 + ((it0 + k) & 3) * 16;
#pragma unroll
                for (int bj = 0; bj < 2; ++bj) {
                    const int col = col0 + bj * 128;
                    if (XIN_BF) xr[k][bj][0] = *(const u32x4*)((const bf16_t*)xin + (size_t)row_ * DM + col);
                    else { xr[k][bj][0] = *(const u32x4*)((const float*)xin + (size_t)row_ * DM + col); xr[k][bj][XIN_BF ? 0 : 1] = *(const u32x4*)((const float*)xin + (size_t)row_ * DM + col + 4); }
                }
            }
#pragma unroll
            for (int k = 0; k < NB; ++k) {
                const int it = it0 + k, ai = it >> 2, m = it & 3, row = row0 + ai * 128 + m * 16;
                float s2 = 0.f;
#pragma unroll
                for (int bj = 0; bj < 2; ++bj) {
                    const int col = col0 + bj * 128;
                    f32x4 x0, x1;
                    if (XIN_BF) { x0 = bf4_lo(xr[k][bj][0]); x1 = bf4_hi(xr[k][bj][0]); }
                    else { x0 = __builtin_bit_cast(f32x4, xr[k][bj][0]); x1 = __builtin_bit_cast(f32x4, xr[k][bj][XIN_BF ? 0 : 1]); }
                    f32x4 v0 = x0 + gg[bj][0] * (acc[ai][bj][m][0] * rs1[it]), v1 = x1 + gg[bj][1] * (acc[ai][bj][m][1] * rs1[it]);
                    if (XOUT_BF) { const u32x4 w = pack8(v0, v1, 1.0f); *(u32x4*)((bf16_t*)xout + (size_t)row * DM + col) = w; v0 = bf4_lo(w); v1 = bf4_hi(w); }
                    else { *(f32x4*)((float*)xout + (size_t)row * DM + col) = v0; *(f32x4*)((float*)xout + (size_t)row * DM + col + 4) = v1; }
                    if (HAS_H) { acc[ai][bj][m][0] = v0; acc[ai][bj][m][1] = v1; s2 += sq8(v0, v1); }
                }
                if (HAS_H) { s2 += __shfl_xor(s2, 16); s2 += __shfl_xor(s2, 32); if (fq == 0) unsafeAtomicAdd(ss2 + row, s2); }
            }
        }
        if (HAS_H) {
            f32x4 hg[2][2], hs[2][2];
#pragma unroll
            for (int bj = 0; bj < 2; ++bj)
#pragma unroll
                for (int hh = 0; hh < 2; ++hh) {
                    const int col = col0 + bj * 128 + 4 * hh;
                    hg[bj][hh] = *(const f32x4*)(gpre + col) * (1.0f + *(const f32x4*)(scale + (size_t)bb * NMOD + col));
                    hs[bj][hh] = *(const f32x4*)(shift + (size_t)bb * NMOD + col);
                }
            panel_wait(cnt + pm * 64, 16u, ctl);
            float rs2[8];
#pragma unroll
            for (int it = 0; it < 8; ++it) rs2[it] = __hip_atomic_load(ss2 + row0 + (it >> 2) * 128 + (it & 3) * 16, __ATOMIC_RELAXED, __HIP_MEMORY_SCOPE_AGENT);
#pragma unroll
            for (int it = 0; it < 8; ++it) {
                const int ai = it >> 2, m = it & 3, row = row0 + ai * 128 + m * 16;
                const float rstd2 = rsqrtf(rs2[it] * (1.0f / DM) + EPS);
#pragma unroll
                for (int bj = 0; bj < 2; ++bj) {
                    const f32x4 h0 = (acc[ai][bj][m][0] * rstd2) * hg[bj][0] + hs[bj][0], h1 = (acc[ai][bj][m][1] * rstd2) * hg[bj][1] + hs[bj][1];
                    *(u32x4*)(H + (size_t)row * DM + col0 + bj * 128) = pack8(h0, h1, 1.0f);
                }
            }
        }
    }
};

__constant__ unsigned char ATT_ORDER[32] = {15, 14, 13, 12, 31, 30, 11, 29, 10, 28, 9, 27, 8, 26, 25, 7, 24, 6, 23, 5, 22, 4, 21, 20, 3, 19, 2, 18, 1, 17, 0, 16};

#define WSP(T, off) ((T*)(ws + (off)))
#ifdef USE_CG_SYNC
#define GSYNC() grid.sync()
#else
#define GSYNC() xcd_barrier()
#endif
#ifdef LEAK_A
#define TS(i) do { if (blockIdx.x == 0 && threadIdx.x == 0) { KP kq = kparams(); ((unsigned long long*)(kq->ws + WS_END))[i] = __builtin_amdgcn_s_memrealtime(); } } while (0)
#else
#define TS(i) do { } while (0)
#endif
__global__ void __launch_bounds__(512) mega(Params p_unused) {
    cg::grid_group grid = cg::this_grid();
    xcd_barrier_post();
    TS(0);
    if (PH(0)) {
        KP kp = kparams(); unsigned char* ws = kp->ws;
        ada_gemv(kp->w_ada, kp->b_ada, kp->c, ws);
        asm volatile("s_waitcnt vmcnt(0)" ::: "memory");
        __syncthreads();
        if (threadIdx.x == 0) { unsigned nu = 0; for (int u = blockIdx.x; u < 9 * 32; u += gridDim.x) ++nu; if (nu) xb_add((unsigned*)(ws + WS_BAR) + CTL_GEMV, nu); }
        rope_table(ws);
        for (int rep = 0; rep < REPS(0); ++rep) {
        conv_weight(MapUp{kp->w1g, kp->w1u}, WSP(bf16_t, WS_BT1U), 2 * DFF, DM, DFF, nullptr, (int)gridDim.x == 256 ? 32 : 0, 0);
        conv_weight(MapPlain{kp->w1d}, WSP(bf16_t, WS_BT1D), DM, DFF, DM, nullptr, 0, 128);
        conv_weight(MapIn{kp->w_in}, WSP(bf16_t, WS_BTIN), 4096, DM, 3912, nullptr);
        conv_weight(MapUq{kp->w_uq}, WSP(bf16_t, WS_BTUQ), 1536, 512, 1536, kp->g_qa, 0, 0);
        conv_weight(MapUkv{kp->w_ukv}, WSP(bf16_t, WS_BTUKV), 2048, 256, 2048, kp->g_kva, 0, 160);
        conv_weight(MapPlain{kp->w_o}, WSP(bf16_t, WS_BTO), DM, DM, DM, nullptr);
        conv_weight(MapUp{kp->w2g, kp->w2u}, WSP(bf16_t, WS_BT2U), 2 * DFF, DM, DFF, nullptr);
        conv_weight(MapPlain{kp->w2d}, WSP(bf16_t, WS_BT2D), DM, DFF, DM, nullptr, 0, 0);
        }
    }
    TS(1);
    if (PH(1)) {
        { KP kp = kparams(); unsigned* ctl = (unsigned*)(kp->ws + WS_BAR);
          if (threadIdx.x == 0) { XB_SPIN(xb_ld(&ctl[CTL_GEMV]) < 288u, ctl); __builtin_amdgcn_fence(__ATOMIC_ACQUIRE, "agent"); asm volatile("s_waitcnt vmcnt(0)" ::: "memory"); }
          __syncthreads(); }
        for (int rep = 0; rep < REPS(1); ++rep) { KP kp = kparams(); unsigned char* ws = kp->ws; const float* mod = WSP(float, WS_MOD);
        rowpass<false, true, false, false>(kp->x, nullptr, nullptr, nullptr, nullptr, nullptr, 0.f, kp->g1pre, mod + 0 * DM, mod + 1 * DM, WSP(bf16_t, WS_H)); }
    }
    { KP kp = kparams(); if (kp->out == nullptr) grid.sync(); }
    GSYNC();
    TS(2);
    if (PH(2)) for (int rep = 0; rep < REPS(2); ++rep) { KP kp = kparams(); unsigned char* ws = kp->ws;
        gemm_phase<SPLIT_TAIL != 0>(WSP(bf16_t, WS_H), WSP(bf16_t, WS_BT1U), NTOK, 2 * DFF, DM, EpiSwiglu{WSP(bf16_t, WS_U)}, rep ? PROBE_ULIMIT : 0x7fffffff,
                   WSP(float, WS_SLAB), WSP(unsigned, WS_FLAG), WSP(unsigned, WS_BAR)); }
    GSYNC();
    TS(3);
#if FUSE_RES
    if (PH(3)) { KP kp = kparams(); unsigned char* ws = kp->ws; const float* mod = WSP(float, WS_MOD);
        gemm_phase(WSP(bf16_t, WS_U), WSP(bf16_t, WS_BT1D), NTOK, DM, DFF,
                   EpiRes<false, true, true>{kp->x, WSP(bf16_t, WS_X1), WSP(float, WS_SS) + 0 * NTOK, WSP(float, WS_SS) + 6 * NTOK, WSP(unsigned, WS_CNT) + 0 * 32 * 64, WSP(unsigned, WS_BAR),
                                             kp->g1post, mod + 2 * DM, 0.5f, kp->gmpre, mod + 3 * DM, mod + 4 * DM, WSP(bf16_t, WS_H)}); }
    GSYNC();
    TS(4);
    TS(5);
#else
    if (PH(3)) for (int rep = 0; rep < REPS(3); ++rep) { KP kp = kparams(); unsigned char* ws = kp->ws;
        gemm_phase(WSP(bf16_t, WS_U), WSP(bf16_t, WS_BT1D), NTOK, DM, DFF, EpiY{WSP(bf16_t, WS_Y), DM, SSP(0)}); }
    GSYNC();
    TS(4);
    if (PH(4)) for (int rep = 0; rep < REPS(4); ++rep) { KP kp = kparams(); unsigned char* ws = kp->ws; const float* mod = WSP(float, WS_MOD);
        rowpass<true, true, false, true>(kp->x, WSP(bf16_t, WS_X1), WSP(bf16_t, WS_Y), WSP(float, WS_SS) + 0 * NTOK, kp->g1post, mod + 2 * DM, 0.5f, kp->gmpre, mod + 3 * DM, mod + 4 * DM, WSP(bf16_t, WS_H)); }
    GSYNC();
    TS(5);
#endif
#ifdef PROBE_NULL_IN
    if (PH(5)) { KP kp = kparams(); unsigned char* ws = kp->ws;
        gemm_phase(WSP(bf16_t, WS_H), WSP(bf16_t, WS_BTIN), NTOK, 4096, DM, EpiNull{WSP(float, WS_SS) + 5 * NTOK}); }
#endif
    if (PH(5)) for (int rep = 0; rep < REPS(5); ++rep) { KP kp = kparams(); unsigned char* ws = kp->ws;
        gemm_phase(WSP(bf16_t, WS_H), WSP(bf16_t, WS_BTIN), NTOK, 4096, DM,
                   EpiIn{WSP(bf16_t, WS_QA), WSP(bf16_t, WS_KVA), WSP(bf16_t, WS_KR), WSP(bf16_t, WS_FQ), WSP(bf16_t, WS_FK), WSP(bf16_t, WS_VTF), SSP(1),
                         SSP(2), WSP(float, WS_LOGF), WSP(float, WS_ROPEC), WSP(float, WS_ROPES), kp->b_forget}); }
    GSYNC();
    TS(6);
    if (PH(6)) { KP kp = kparams(); unsigned char* ws = kp->ws;
        if ((phase_tid() >> 6) == 0) for (int bh = (int)(gridDim.x - 1 - blockIdx.x); bh < 16; bh += gridDim.x) cumsum_unit(WSP(float, WS_LOGF), WSP(float, WS_CUM), bh); }
    if (PH(6)) for (int rep = 0; rep < REPS(6); ++rep) { KP kp = kparams(); unsigned char* ws = kp->ws;
        gemm_phase(WSP(bf16_t, WS_QA), WSP(bf16_t, WS_BTUQ), NTOK, 1536, 512, EpiQ{WSP(bf16_t, WS_QM), WSP(float, WS_SS) + 1 * NTOK, WSP(float, WS_ROPEC), WSP(float, WS_ROPES)}); }
    if (PH(7)) for (int rep = 0; rep < REPS(7); ++rep) { KP kp = kparams(); unsigned char* ws = kp->ws;
        gemm_phase(WSP(bf16_t, WS_KVA), WSP(bf16_t, WS_BTUKV), NTOK, 2048, 256, EpiKV{WSP(bf16_t, WS_KN), WSP(bf16_t, WS_VTM), WSP(float, WS_SS) + 2 * NTOK}); }
    GSYNC();
    TS(7);
    {
        extern __shared__ __attribute__((aligned(16))) unsigned char shm[];
        volatile LAS unsigned* slot = (volatile LAS unsigned*)((LAS unsigned char*)shm + LDS_MAIN + 16);
        bool first = true;
        for (;;) {
            __syncthreads();
            if (threadIdx.x == 0) { KP kq = kparams(); slot[0] = first ? blockIdx.x : gridDim.x + xb_add((unsigned*)(kq->ws + WS_BAR) + CTL_QUEUE, 1u); }
            first = false;
            __syncthreads();
            const unsigned sl = slot[0];
            if (sl >= 512u * (unsigned)REPS(8)) break;
            const int i = (int)(sl & 511u), e = ATT_ORDER[i >> 4], bh = i & 15, b = bh >> 3, h = bh & 7, qb = e & 15;
            KP kp = kparams(); unsigned char* ws = kp->ws;
            if (e < 16) {
                if (PH(8)) attn_item<192, false>(WSP(bf16_t, WS_QM) + (size_t)b * SEQ * 1536 + h * 192, 1536, WSP(bf16_t, WS_KN) + (size_t)b * SEQ * 1024 + h * 128, WSP(bf16_t, WS_KR) + (size_t)b * SEQ * 64,
                                      WSP(bf16_t, WS_VTM) + (size_t)bh * 128 * SEQ, nullptr, WSP(bf16_t, WS_O) + (size_t)b * SEQ * DM + h * 128, qb);
            } else {
                if (PH(9)) attn_item<128, true>(WSP(bf16_t, WS_FQ) + (size_t)b * SEQ * 1024 + h * 128, 1024, WSP(bf16_t, WS_FK) + (size_t)b * SEQ * 1024 + h * 128, nullptr,
                                     WSP(bf16_t, WS_VTF) + (size_t)bh * 128 * SEQ, WSP(float, WS_CUM) + (size_t)bh * SEQ, WSP(bf16_t, WS_O) + (size_t)b * SEQ * DM + 1024 + h * 128, qb);
            }
        }
    }
    GSYNC();
    TS(8);
#if FUSE_RES
    if (PH(10)) { KP kp = kparams(); unsigned char* ws = kp->ws; const float* mod = WSP(float, WS_MOD);
        gemm_phase(WSP(bf16_t, WS_O), WSP(bf16_t, WS_BTO), NTOK, DM, DM,
                   EpiRes<true, true, true>{WSP(bf16_t, WS_X1), WSP(bf16_t, WS_X1), WSP(float, WS_SS) + 3 * NTOK, WSP(float, WS_SS) + 7 * NTOK, WSP(unsigned, WS_CNT) + 1 * 32 * 64, WSP(unsigned, WS_BAR),
                                            kp->gmpost, mod + 5 * DM, 1.0f, kp->g2pre, mod + 6 * DM, mod + 7 * DM, WSP(bf16_t, WS_H)}); }
    GSYNC();
    TS(9);
    TS(10);
#else
    if (PH(10)) for (int rep = 0; rep < REPS(10); ++rep) { KP kp = kparams(); unsigned char* ws = kp->ws;
        gemm_phase(WSP(bf16_t, WS_O), WSP(bf16_t, WS_BTO), NTOK, DM, DM, EpiY{WSP(bf16_t, WS_Y), DM, SSP(3)}); }
    GSYNC();
    TS(9);
    if (PH(11)) { KP kp = kparams(); unsigned char* ws = kp->ws; const float* mod = WSP(float, WS_MOD);
        rowpass<true, true, true, true>(WSP(bf16_t, WS_X1), WSP(bf16_t, WS_X1), WSP(bf16_t, WS_Y), WSP(float, WS_SS) + 3 * NTOK, kp->gmpost, mod + 5 * DM, 1.0f, kp->g2pre, mod + 6 * DM, mod + 7 * DM, WSP(bf16_t, WS_H)); }
    GSYNC();
    TS(10);
#endif
    if (PH(12)) for (int rep = 0; rep < REPS(12); ++rep) { KP kp = kparams(); unsigned char* ws = kp->ws;
        gemm_phase<SPLIT_TAIL != 0>(WSP(bf16_t, WS_H), WSP(bf16_t, WS_BT2U), NTOK, 2 * DFF, DM, EpiSwiglu{WSP(bf16_t, WS_U)}, 0x7fffffff,
                   WSP(float, WS_SLAB) + (size_t)128 * 65536, WSP(unsigned, WS_FLAG) + 128 * 16, WSP(unsigned, WS_BAR)); }
    GSYNC();
    TS(11);
#if FUSE_RES
    if (PH(13)) { KP kp = kparams(); unsigned char* ws = kp->ws; const float* mod = WSP(float, WS_MOD);
        gemm_phase(WSP(bf16_t, WS_U), WSP(bf16_t, WS_BT2D), NTOK, DM, DFF,
                   EpiRes<true, false, false>{WSP(bf16_t, WS_X1), kp->out, WSP(float, WS_SS) + 4 * NTOK, nullptr, WSP(unsigned, WS_CNT) + 2 * 32 * 64, WSP(unsigned, WS_BAR),
                                              kp->g2post, mod + 8 * DM, 0.5f, nullptr, nullptr, nullptr, nullptr}); }
#else
    if (PH(13)) for (int rep = 0; rep < REPS(13); ++rep) { KP kp = kparams(); unsigned char* ws = kp->ws;
        gemm_phase(WSP(bf16_t, WS_U), WSP(bf16_t, WS_BT2D), NTOK, DM, DFF, EpiY{WSP(bf16_t, WS_Y), DM, SSP(4)}); }
    GSYNC();
    TS(12);
    if (PH(14)) { KP kp = kparams(); unsigned char* ws = kp->ws; const float* mod = WSP(float, WS_MOD);
        rowpass<true, false, true, false>(WSP(bf16_t, WS_X1), kp->out, WSP(bf16_t, WS_Y), WSP(float, WS_SS) + 4 * NTOK, kp->g2post, mod + 8 * DM, 0.5f, nullptr, nullptr, nullptr, nullptr); }
#endif
#ifdef LEAK_A
    GSYNC();
    TS(13);
    GSYNC();
    {
        KP kp = kparams(); const unsigned long long* tsp = (const unsigned long long*)(kp->ws + WS_END);
        float A = 0.f, B = 0.f;
        for (int i = 0; i < 13; ++i) {
            const float dt = (float)(tsp[i + 1] - tsp[i]) * 0.01f;
            if ((LEAK_A >> i) & 1) A += dt;
            if ((LEAK_B >> i) & 1) B += dt;
        }
        float* o = kp->out;
        for (size_t i = (size_t)blockIdx.x * 512 + threadIdx.x; i < (size_t)NTOK * DM; i += (size_t)gridDim.x * 512) o[i] = (i == 0) ? A * 1000.f : B;
    }
#endif
}

extern "C" void kernel_launch(void* const* d_in, const int* in_sizes, int n_in, void* d_out, int out_size, void* d_ws, size_t ws_size, hipStream_t stream) {
    static int grid_blocks = 0;
    if (!grid_blocks) {
        int dev = 0, cus = 0, per_cu = 0;
        hipGetDevice(&dev);
        hipDeviceGetAttribute(&cus, hipDeviceAttributeMultiprocessorCount, dev);
        hipFuncSetAttribute((const void*)mega, hipFuncAttributeMaxDynamicSharedMemorySize, LDS_BYTES);
        hipOccupancyMaxActiveBlocksPerMultiprocessor(&per_cu, mega, 512, LDS_BYTES);
        if (per_cu < 1) per_cu = 1;
        if (per_cu > 1) per_cu = 1;
        grid_blocks = cus * per_cu;
        grid_blocks &= ~7;
        if (grid_blocks > 256) grid_blocks = 256;
    }
    if (ws_size < WS_END) { fprintf(stderr, "workspace too small\n"); return; }
    if (FUSE_RES && grid_blocks != 256) { fprintf(stderr, "fused residual epilogues need a 256-workgroup grid (have %d)\n", grid_blocks); return; }
    Params p{};
    const float** pf = (const float**)&p;
    for (int i = 0; i < 23; ++i) pf[i] = (const float*)d_in[i];
    p.out = (float*)d_out;
    p.ws = (unsigned char*)d_ws;
    hipMemsetAsync(d_ws, 0, WS_ZERO_END, stream);
    void* args[] = {&p};
    hipError_t e = hipLaunchCooperativeKernel((void*)mega, dim3(grid_blocks), dim3(512), args, LDS_BYTES, stream);
    if (e != hipSuccess) fprintf(stderr, "cooperative launch failed: %s (grid %d)\n", hipGetErrorString(e), grid_blocks);
}
```
